# Optimizing an MI355X kernel written in HIP

```python
import jax, jax.numpy as jnp
from jax import lax
import numpy as np

D_MODEL = 1024
BATCH = 8
SEQ = 2048
DEPTH = 1
DEC_BATCH = 128
DEC_SEQ = 1
PAST_LEN = 16384
PAGE_SIZE = 128

N_HEADS = 8
HEAD_K = D_MODEL // N_HEADS
HEAD_V = D_MODEL // N_HEADS
D_HGRN = N_HEADS * HEAD_K
D_CONV = D_MODEL
CONV_W = 3
N_META = 16
CHUNK = 32
EPS = 1e-6
SPLIT_WIDTHS = (D_HGRN, D_HGRN, N_HEADS * HEAD_V, N_HEADS * HEAD_V,
                D_CONV, D_CONV, D_CONV, D_CONV, D_MODEL, D_MODEL)
D_IN = sum(SPLIT_WIDTHS)

kernel_name = "hgrn2_shortconv_gated_hybrid_step"


def rmsnorm(x, w):
    xf = x.astype(jnp.float32)
    var = jnp.mean(xf * xf, axis=-1, keepdims=True)
    return (xf * lax.rsqrt(var + EPS) * w.astype(jnp.float32)).astype(x.dtype)


def gla_chunk(S, q, k, v, g):
    C = q.shape[2]
    G = jnp.cumsum(g, axis=2)
    o_inter = jnp.einsum('nhtk,nhkv->nhtv', q * jnp.exp(G), S)
    causal = jnp.tril(jnp.ones((C, C), dtype=bool))[None, None, :, :, None]
    diff = G[:, :, :, None, :] - G[:, :, None, :, :]
    decay = jnp.where(causal, jnp.exp(jnp.where(causal, diff, 0.0)), 0.0)
    scores = jnp.einsum('nhtk,nhsk,nhtsk->nhts', q, k, decay)
    o_intra = jnp.einsum('nhts,nhsv->nhtv', scores, v)
    G_last = G[:, :, -1:, :]
    S_new = jnp.exp(G_last[:, :, 0, :])[..., None] * S + jnp.einsum(
        'nhsk,nhsv->nhkv', k * jnp.exp(G_last - G), v)
    return S_new, o_inter + o_intra


def hgrn_mix(q, k, v, g, S0, lead, chunk):
    N, H, L, _ = q.shape
    S = S0
    outs = []
    if lead > 0:
        S, o = gla_chunk(S, q[:, :, :lead], k[:, :, :lead], v[:, :, :lead], g[:, :, :lead])
        outs.append(o)
    rest = L - lead
    n = rest // chunk

    def to_blocks(a):
        a = a[:, :, lead:]
        return a.reshape(N, H, n, chunk, a.shape[-1]).transpose(2, 0, 1, 3, 4)

    S, oc = lax.scan(lambda s, xs: gla_chunk(s, *xs), S,
                     (to_blocks(q), to_blocks(k), to_blocks(v), to_blocks(g)))
    outs.append(oc.transpose(1, 2, 0, 3, 4).reshape(N, H, rest, HEAD_V))
    return jnp.concatenate(outs, axis=2), S


def mixer_layer(h, conv_ctx, S0, lb, w_in, norm_pre, norm_post, hgrn_norm, conv_w,
                w_a, w_b, w_o, lead, chunk):
    N, L, _ = h.shape
    xn = rmsnorm(h, norm_pre)
    proj = xn @ w_in
    idx = np.cumsum(SPLIT_WIDTHS)[:-1].tolist()
    q, fr, i_in, z_a, b_g, c_g, h_c, z_b, gate_a, gate_b = jnp.split(proj, idx, axis=-1)

    lbf = lb.astype(jnp.float32)
    f = lbf + (1.0 - lbf) * jax.nn.sigmoid(fr.astype(jnp.float32))
    log_f = jnp.log(f)
    k_in = 1.0 - f
    qa = jax.nn.silu(q.astype(jnp.float32))

    def heads(a):
        return a.reshape(N, L, N_HEADS, -1).transpose(0, 2, 1, 3)

    o, S_new = hgrn_mix(heads(qa), heads(k_in), heads(i_in.astype(jnp.float32)),
                        heads(log_f), S0.astype(jnp.float32), lead, chunk)
    o = o.transpose(0, 2, 1, 3)
    o = o * lax.rsqrt(jnp.mean(o * o, axis=-1, keepdims=True) + EPS) * hgrn_norm.astype(jnp.float32)
    o = o.reshape(N, L, N_HEADS * HEAD_V).astype(h.dtype) * jax.nn.silu(z_a)
    y_a = o @ w_a

    u = c_g * h_c
    u_ext = jnp.concatenate([conv_ctx.astype(u.dtype), u], axis=1)
    conv = sum(conv_w[j] * u_ext[:, j:j + L] for j in range(CONV_W))
    y_b = (b_g * conv * jax.nn.silu(z_b)) @ w_b
    new_ctx = u_ext[:, -(CONV_W - 1):]

    merged = jax.nn.sigmoid(gate_a) * y_a + jax.nn.sigmoid(gate_b) * y_b
    out = merged @ w_o
    h = h + rmsnorm(out, norm_post)
    return h, new_ctx, S_new


def setup_inputs(seed: int = 0) -> dict:
    key = jax.random.key(seed)
    ks = jax.random.split(key, 16)
    f32 = jnp.float32
    nrm = lambda k, s, sc: jax.random.normal(k, s, f32) * sc
    return {
        "x_prompt": nrm(ks[0], (BATCH, SEQ, D_MODEL), 1.0),
        "x_sample": nrm(ks[1], (DEC_BATCH, DEC_SEQ, D_MODEL), 1.0),
        "state_hgrn": nrm(ks[2], (DEPTH, DEC_BATCH, N_HEADS, HEAD_K, HEAD_V), 0.5),
        "state_conv": nrm(ks[3], (DEPTH, DEC_BATCH, CONV_W - 1, D_CONV), 0.5),
        "meta_tokens": nrm(ks[4], (N_META, D_MODEL), 1.0),
        "w_in": nrm(ks[5], (DEPTH, D_MODEL, D_IN), D_MODEL ** -0.5),
        "norm_pre": 1.0 + nrm(ks[6], (DEPTH, D_MODEL), 0.02),
        "norm_post": 1.0 + nrm(ks[7], (DEPTH, D_MODEL), 0.02),
        "lb_logits": nrm(ks[8], (DEPTH + 1, D_HGRN), 0.5),
        "hgrn_norm": 1.0 + nrm(ks[9], (DEPTH, HEAD_V), 0.02),
        "conv_w": nrm(ks[10], (DEPTH, CONV_W, D_CONV), CONV_W ** -0.5),
        "w_a": nrm(ks[11], (DEPTH, N_HEADS * HEAD_V, D_MODEL), (N_HEADS * HEAD_V) ** -0.5),
        "w_b": nrm(ks[12], (DEPTH, D_CONV, D_MODEL), D_CONV ** -0.5),
        "w_o": nrm(ks[13], (DEPTH, D_MODEL, D_MODEL), D_MODEL ** -0.5),
    }


def reference(x_prompt, x_sample, state_hgrn, state_conv, meta_tokens, w_in, norm_pre,
              norm_post, lb_logits, hgrn_norm, conv_w, w_a, w_b, w_o):
    lower_bounds = jnp.cumsum(jax.nn.softmax(lb_logits.astype(jnp.float32), axis=0), axis=0)

    hp = jnp.concatenate([jnp.broadcast_to(meta_tokens.astype(x_prompt.dtype)[None],
                                           (BATCH, N_META, D_MODEL)), x_prompt], axis=1)
    conv0 = jnp.zeros((BATCH, CONV_W - 1, D_CONV), x_prompt.dtype)
    S0 = jnp.zeros((BATCH, N_HEADS, HEAD_K, HEAD_V), jnp.float32)
    hs = x_sample
    hgrn_p, hgrn_s, conv_p, conv_s = [], [], [], []
    for l in range(DEPTH):
        hp, cp, sp = mixer_layer(hp, conv0, S0, lower_bounds[l], w_in[l], norm_pre[l], norm_post[l],
                                 hgrn_norm[l], conv_w[l], w_a[l], w_b[l], w_o[l], N_META, CHUNK)
        hs, cs, ss = mixer_layer(hs, state_conv[l], state_hgrn[l], lower_bounds[l], w_in[l],
                                 norm_pre[l], norm_post[l], hgrn_norm[l], conv_w[l], w_a[l],
                                 w_b[l], w_o[l], 0, DEC_SEQ)
        hgrn_p.append(sp); hgrn_s.append(ss); conv_p.append(cp); conv_s.append(cs)
    y_prompt = hp[:, N_META:]
    y_sample = hs
    return (y_prompt, y_sample, jnp.stack(hgrn_p), jnp.stack(hgrn_s),
            jnp.stack(conv_p), jnp.stack(conv_s))
```

```cpp
#include <hip/hip_runtime.h>
#include <cstdint>
#include <cstdio>

typedef unsigned short bf16_t;

constexpr int D = 1024, NB = 8, SEQ = 2048, NDEC = 128, NMETA = 16, NH = 8, HD = 128, DIN = 10240;
constexpr int M_MAIN = NB * SEQ;
constexpr int NX = NDEC + NMETA;
constexpr int NXA = 160;
constexpr int NXP = 256;
constexpr int CHK = 32, NCHUNK = M_MAIN / CHK;
constexpr float EPS = 1e-6f;

constexpr size_t O_YP = 0, O_YS = 16777216, O_HP = O_YS + 131072, O_HS = O_HP + 1048576, O_CP = O_HS + 16777216, O_CS = O_CP + 16384;

constexpr size_t MiB = 1u << 20;
constexpr size_t WS_CTL = 0, WS_WIN = 1 * MiB, WS_WAB = 21 * MiB, WS_WO = 25 * MiB, WS_DL = 27 * MiB, WS_X = 30 * MiB;
constexpr size_t XSTRIDE = (size_t)NXA * D * 4;
constexpr size_t WS_A12X = 36 * MiB, WS_MGX = 37 * MiB;
constexpr size_t WS_QT = 38 * MiB, WS_KH = 70 * MiB, WS_V = 102 * MiB, WS_A12 = 134 * MiB, WS_U = 198 * MiB, WS_MG = WS_QT;
enum { X_Q = 0, X_K, X_F, X_V, X_SZA, X_W, X_U, X_RT, X_GB, X_N };

struct Params {
    const float *x_prompt, *x_sample, *state_hgrn, *state_conv, *meta, *w_in, *norm_pre, *norm_post, *lb_logits, *hgrn_norm, *conv_w, *w_a, *w_b, *w_o;
    float* out;
    unsigned char* ws;
};
__device__ __forceinline__ bf16_t* WIN_T(const Params& p) { return (bf16_t*)(p.ws + WS_WIN); }
__device__ __forceinline__ bf16_t* WAB_T(const Params& p) { return (bf16_t*)(p.ws + WS_WAB); }
__device__ __forceinline__ bf16_t* WO_T(const Params& p) { return (bf16_t*)(p.ws + WS_WO); }
__device__ __forceinline__ float* DLp(const Params& p) { return (float*)(p.ws + WS_DL); }
__device__ __forceinline__ float* XA(const Params& p, int i) { return (float*)(p.ws + WS_X + (size_t)i * XSTRIDE); }
__device__ __forceinline__ bf16_t* A12X(const Params& p) { return (bf16_t*)(p.ws + WS_A12X); }
__device__ __forceinline__ bf16_t* MGX(const Params& p) { return (bf16_t*)(p.ws + WS_MGX); }
__device__ __forceinline__ bf16_t* QT(const Params& p) { return (bf16_t*)(p.ws + WS_QT); }
__device__ __forceinline__ bf16_t* KH(const Params& p) { return (bf16_t*)(p.ws + WS_KH); }
__device__ __forceinline__ bf16_t* VV(const Params& p) { return (bf16_t*)(p.ws + WS_V); }
__device__ __forceinline__ bf16_t* A12(const Params& p) { return (bf16_t*)(p.ws + WS_A12); }
__device__ __forceinline__ bf16_t* UU(const Params& p) { return (bf16_t*)(p.ws + WS_U); }
__device__ __forceinline__ bf16_t* MG(const Params& p) { return (bf16_t*)(p.ws + WS_MG); }
__device__ __forceinline__ bf16_t* XN(const Params& p) { return (bf16_t*)(p.out + O_HS); }
__device__ __forceinline__ bf16_t* RT(const Params& p) { return (bf16_t*)(p.out + O_YP); }
__device__ __forceinline__ bf16_t* GB(const Params& p) { return (bf16_t*)(p.out + O_YP) + (size_t)M_MAIN * D; }

__device__ __forceinline__ float bf2f(bf16_t h) { return __uint_as_float(((unsigned)h) << 16); }
__device__ __forceinline__ bf16_t f2bf(float f) { unsigned u = __float_as_uint(f); return (bf16_t)((u + 0x7fffu + ((u >> 16) & 1u)) >> 16); }
__device__ __forceinline__ float clampf(float x, float lo, float hi) { return fminf(fmaxf(x, lo), hi); }
__device__ __forceinline__ float sigm(float x) { return 1.f / (1.f + __expf(-clampf(x, -30.f, 30.f))); }
__device__ __forceinline__ float silu(float x) { return x * sigm(x); }
__device__ __forceinline__ void unpack8(uint4 v, float* f) {
    f[0] = __uint_as_float(v.x << 16); f[1] = __uint_as_float(v.x & 0xffff0000u); f[2] = __uint_as_float(v.y << 16); f[3] = __uint_as_float(v.y & 0xffff0000u);
    f[4] = __uint_as_float(v.z << 16); f[5] = __uint_as_float(v.z & 0xffff0000u); f[6] = __uint_as_float(v.w << 16); f[7] = __uint_as_float(v.w & 0xffff0000u);
}
__device__ __forceinline__ uint4 pack8(const float* f) {
    uint4 v; v.x = f2bf(f[0]) | ((unsigned)f2bf(f[1]) << 16); v.y = f2bf(f[2]) | ((unsigned)f2bf(f[3]) << 16);
    v.z = f2bf(f[4]) | ((unsigned)f2bf(f[5]) << 16); v.w = f2bf(f[6]) | ((unsigned)f2bf(f[7]) << 16); return v;
}
__host__ __device__ __forceinline__ int srccol(int n) {
    const int pn = n >> 8, bj = (n >> 7) & 1, j = n & 127, T = pn >> 3, cb = pn & 7;
    const int split = ((bj ? 0x96731 : 0x85420) >> (4 * T)) & 15;
    return split * 1024 + cb * 128 + j;
}
__device__ __forceinline__ int nrow_x(int T, int c) { return 256 * (T * 8 + (c >> 7)) + (c & 127); }
__device__ __forceinline__ float lbound(const Params& p, int c) { return 1.f / (1.f + __expf(p.lb_logits[1024 + c] - p.lb_logits[c])); }

__global__ void nk_wconv(Params p) {
    int n = blockIdx.x;
    if (n < DIN) { const int src = srccol(n); bf16_t* o = WIN_T(p) + (size_t)n * D; for (int k = threadIdx.x; k < D; k += 256) o[k] = f2bf(p.w_in[(size_t)k * DIN + src]); return; }
    n -= DIN;
    if (n < D) { bf16_t* o = WAB_T(p) + (size_t)n * 2048; for (int k = threadIdx.x; k < 2048; k += 256) o[k] = f2bf(k < D ? p.w_a[(size_t)k * D + n] : p.w_b[(size_t)(k - D) * D + n]); return; }
    n -= D;
    { bf16_t* o = WO_T(p) + (size_t)n * D; for (int k = threadIdx.x; k < D; k += 256) o[k] = f2bf(p.w_o[(size_t)k * D + n]); }
}
__device__ __forceinline__ float block_sum256(float v, float* red) {
    for (int o = 32; o > 0; o >>= 1) v += __shfl_xor(v, o);
    __syncthreads();
    if ((threadIdx.x & 63) == 0) red[threadIdx.x >> 6] = v;
    __syncthreads();
    return red[0] + red[1] + red[2] + red[3];
}
__global__ void nk_rmsnorm(Params p) {
    __shared__ float red[4];
    const int r = blockIdx.x; bf16_t* o = XN(p) + (size_t)r * D + threadIdx.x * 4;
    const float* src = nullptr;
    if (r < M_MAIN) src = p.x_prompt + (size_t)r * D; else if (r < M_MAIN + NDEC) src = p.x_sample + (size_t)(r - M_MAIN) * D; else if (r < M_MAIN + NX) src = p.meta + (size_t)(r - M_MAIN - NDEC) * D;
    if (!src) { o[0] = o[1] = o[2] = o[3] = 0; return; }
    const float4 v = ((const float4*)src)[threadIdx.x];
    const float ss = block_sum256(v.x * v.x + v.y * v.y + v.z * v.z + v.w * v.w, red);
    const float rs = rsqrtf(ss * (1.f / D) + EPS); const float4 w = ((const float4*)p.norm_pre)[threadIdx.x];
    o[0] = f2bf(v.x * rs * w.x); o[1] = f2bf(v.y * rs * w.y); o[2] = f2bf(v.z * rs * w.z); o[3] = f2bf(v.w * rs * w.w);
}
__device__ __forceinline__ void dots16(const bf16_t* arow, const bf16_t* wx0, float* x, float* y) {
    _Pragma("unroll") for (int j = 0; j < 8; ++j) { x[j] = 0.f; y[j] = 0.f; }
    const uint4* a = (const uint4*)arow;
    for (int k8 = 0; k8 < 128; ++k8) {
        float av[8]; unpack8(a[k8], av);
#pragma unroll
        for (int j = 0; j < 8; ++j) {
            float wv[8]; unpack8(((const uint4*)(wx0 + (size_t)j * D))[k8], wv);
            float s = 0.f;
#pragma unroll
            for (int e = 0; e < 8; ++e) s += av[e] * wv[e];
            x[j] += s;
            unpack8(((const uint4*)(wx0 + (size_t)(j + 128) * D))[k8], wv);
            s = 0.f;
#pragma unroll
            for (int e = 0; e < 8; ++e) s += av[e] * wv[e];
            y[j] += s;
        }
    }
}
__global__ void nk_p1(Params p) {
    __shared__ float gs[32][65];
    const int tid = threadIdx.x, r = tid >> 3, cg = tid & 7;
    const int T = blockIdx.y >> 4, c0 = (blockIdx.y & 15) * 64 + cg * 8;
    const bool main = blockIdx.x < NCHUNK;
    const int row = main ? blockIdx.x * 32 + r : M_MAIN + (blockIdx.x - NCHUNK) * 32 + r;
    float x[8], y[8];
    dots16(XN(p) + (size_t)row * D, WIN_T(p) + (size_t)nrow_x(T, c0) * D, x, y);
    if (!main) {
        const int e = row - M_MAIN;
        _Pragma("unroll") for (int j = 0; j < 8; ++j) {
            const int c = c0 + j; const size_t o = (size_t)e * D + c;
            if (T == 0) { const float lb = lbound(p, c); const float ee = __expf(-clampf(y[j], -30.f, 30.f)), sg = 1.f / (1.f + ee);
                XA(p, X_Q)[o] = silu(x[j]); XA(p, X_F)[o] = lb + (1.f - lb) * sg; XA(p, X_K)[o] = (1.f - lb) * ee * sg; }
            else if (T == 1) { XA(p, X_V)[o] = x[j]; XA(p, X_SZA)[o] = silu(y[j]); }
            else if (T == 2) { XA(p, X_W)[o] = x[j] * silu(y[j]); }
            else if (T == 3) { XA(p, X_U)[o] = x[j] * y[j]; }
            else { const float ga = sigm(x[j]), gb = sigm(y[j]); XA(p, X_RT)[o] = ga / gb; XA(p, X_GB)[o] = gb; }
        }
        return;
    }
    const size_t o = (size_t)row * D + c0;
    float r0[8], r1[8];
    if (T == 0) {
        float qa[8], kk[8];
        _Pragma("unroll") for (int j = 0; j < 8; ++j) { const float lb = lbound(p, c0 + j); const float ee = __expf(-clampf(y[j], -30.f, 30.f)), sg = 1.f / (1.f + ee);
            qa[j] = silu(x[j]); kk[j] = (1.f - lb) * ee * sg; gs[r][cg * 8 + j] = __logf(lb + (1.f - lb) * sg); }
        __syncthreads();
        if (tid < 64) { float a = 0.f; for (int t = 0; t < 32; ++t) { a += gs[t][tid]; gs[t][tid] = a; } }
        __syncthreads();
        _Pragma("unroll") for (int j = 0; j < 8; ++j) { const float G = fmaxf(gs[r][cg * 8 + j], -80.f); r0[j] = qa[j] * __expf(G); r1[j] = kk[j] * __expf(-G); }
        *(uint4*)(QT(p) + o) = pack8(r0); *(uint4*)(KH(p) + o) = pack8(r1);
        if (r == 31) _Pragma("unroll") for (int j = 0; j < 8; ++j) DLp(p)[(size_t)blockIdx.x * D + c0 + j] = __expf(gs[31][cg * 8 + j]);
    } else if (T == 1) {
        _Pragma("unroll") for (int j = 0; j < 8; ++j) { r0[j] = x[j]; r1[j] = silu(y[j]); }
        *(uint4*)(VV(p) + o) = pack8(r0); *(uint4*)(A12(p) + (size_t)row * 2048 + c0) = pack8(r1);
    } else if (T == 2) {
        _Pragma("unroll") for (int j = 0; j < 8; ++j) r0[j] = x[j] * silu(y[j]);
        *(uint4*)(A12(p) + (size_t)row * 2048 + 1024 + c0) = pack8(r0);
    } else if (T == 3) {
        _Pragma("unroll") for (int j = 0; j < 8; ++j) r0[j] = x[j] * y[j];
        *(uint4*)(UU(p) + o) = pack8(r0);
        const int t = row & (SEQ - 1);
        if (t >= SEQ - 2) { float* cp = p.out + O_CP + ((size_t)(row >> 11) * 2 + (t - (SEQ - 2))) * D + c0; _Pragma("unroll") for (int j = 0; j < 8; ++j) cp[j] = r0[j]; }
    } else {
        _Pragma("unroll") for (int j = 0; j < 8; ++j) { const float ga = sigm(x[j]), gb = sigm(y[j]); r0[j] = ga / gb; r1[j] = gb; }
        *(uint4*)(RT(p) + o) = pack8(r0); *(uint4*)(GB(p) + o) = pack8(r1);
    }
}
__global__ void nk_p2_scan(Params p) {
    extern __shared__ __attribute__((aligned(16))) float sm[];
    float* S = sm;
    float* q = S + 128 * 128;
    float* kh = q + 32 * 128;
    float* vv = kh + 32 * 128;
    float* O = vv + 32 * 128;
    float* P = O + 32 * 128;
    float* dl = P + 32 * 33;
    const int tid = threadIdx.x, b = blockIdx.x >> 3, h = blockIdx.x & 7;
    for (int i = tid; i < 128 * 128; i += 512) S[i] = 0.f;
    __syncthreads();
    for (int j = 0; j < NMETA; ++j) {
        const size_t xo = (size_t)(NDEC + j) * D + h * HD;
        for (int i = tid; i < 128 * 128; i += 512) { const int k = i >> 7, v = i & 127; S[i] = XA(p, X_F)[xo + k] * S[i] + XA(p, X_K)[xo + k] * XA(p, X_V)[xo + v]; }
    }
    __syncthreads();
    for (int c = 0; c < SEQ / CHK; ++c) {
        const size_t row0 = (size_t)b * SEQ + c * CHK;
        for (int i = tid; i < 32 * 128; i += 512) { const int t = i >> 7, k = i & 127; const size_t g = (row0 + t) * D + h * HD + k; q[i] = bf2f(QT(p)[g]); kh[i] = bf2f(KH(p)[g]); vv[i] = bf2f(VV(p)[g]); }
        if (tid < 128) dl[tid] = DLp(p)[((size_t)b * (SEQ / CHK) + c) * D + h * HD + tid];
        __syncthreads();
        for (int i = tid; i < 1024; i += 512) { const int t = i >> 5, s = i & 31; float a = 0.f; if (s <= t) for (int k = 0; k < 128; ++k) a += q[t * 128 + k] * kh[s * 128 + k]; P[t * 33 + s] = a; }
        __syncthreads();
        for (int i = tid; i < 4096; i += 512) { const int t = i >> 7, v = i & 127; float a = 0.f; for (int k = 0; k < 128; ++k) a += q[t * 128 + k] * S[k * 128 + v]; for (int s = 0; s <= t; ++s) a += P[t * 33 + s] * vv[s * 128 + v]; O[i] = a; }
        __syncthreads();
        for (int i = tid; i < 128 * 128; i += 512) { const int k = i >> 7, v = i & 127; float a = S[i]; for (int s = 0; s < 32; ++s) a += kh[s * 128 + k] * vv[s * 128 + v]; S[i] = dl[k] * a; }
        { const int t = tid >> 4, v0 = (tid & 15) * 8; float ss = 0.f; _Pragma("unroll") for (int j = 0; j < 8; ++j) { const float x = O[t * 128 + v0 + j]; ss += x * x; }
          for (int o = 8; o > 0; o >>= 1) ss += __shfl_xor(ss, o);
          const float rs = rsqrtf(ss * (1.f / 128.f) + EPS); bf16_t* a1 = A12(p) + (row0 + t) * 2048 + h * HD + v0; float z[8]; unpack8(*(const uint4*)a1, z);
          _Pragma("unroll") for (int j = 0; j < 8; ++j) z[j] = O[t * 128 + v0 + j] * rs * p.hgrn_norm[v0 + j] * z[j];
          *(uint4*)a1 = pack8(z); }
        __syncthreads();
    }
    float* hp = p.out + O_HP + ((size_t)b * NH + h) * 128 * 128;
    for (int i = tid; i < 128 * 128; i += 512) hp[i] = S[i];
}
__global__ void nk_p2_decode(Params p) {
    __shared__ float red[16][128]; __shared__ float ssq[2];
    const int tid = threadIdx.x, n = blockIdx.x >> 3, h = blockIdx.x & 7, kq = tid >> 5, v4 = tid & 31;
    const size_t xo = (size_t)n * D + h * HD;
    const float* S = p.state_hgrn + ((size_t)n * NH + h) * 128 * 128; float* So = p.out + O_HS + ((size_t)n * NH + h) * 128 * 128;
    const float4 vv = *(const float4*)(XA(p, X_V) + xo + v4 * 4);
    float4 o = {0.f, 0.f, 0.f, 0.f};
    for (int i = 0; i < 8; ++i) { const int k = kq * 8 + i; const float f = XA(p, X_F)[xo + k], kk = XA(p, X_K)[xo + k], qq = XA(p, X_Q)[xo + k];
        float4 s = *(const float4*)(S + k * 128 + v4 * 4); s.x = f * s.x + kk * vv.x; s.y = f * s.y + kk * vv.y; s.z = f * s.z + kk * vv.z; s.w = f * s.w + kk * vv.w;
        *(float4*)(So + k * 128 + v4 * 4) = s; o.x += qq * s.x; o.y += qq * s.y; o.z += qq * s.z; o.w += qq * s.w; }
    *(float4*)&red[kq][v4 * 4] = o;
    __syncthreads();
    float ov = 0.f;
    if (tid < 128) { for (int i = 0; i < 16; ++i) ov += red[i][tid]; float ss = ov * ov; for (int o2 = 32; o2 > 0; o2 >>= 1) ss += __shfl_xor(ss, o2); if ((tid & 63) == 0) ssq[tid >> 6] = ss; }
    __syncthreads();
    if (tid < 128) { const float rs = rsqrtf((ssq[0] + ssq[1]) * (1.f / 128.f) + EPS); A12X(p)[(size_t)n * 2048 + h * HD + tid] = f2bf(ov * rs * p.hgrn_norm[tid] * XA(p, X_SZA)[xo + tid]); }
}
__global__ void nk_p2_conv(Params p) {
    const size_t gid = (size_t)blockIdx.x * 256 + threadIdx.x; const int row = (int)(gid >> 7), c0 = (int)(gid & 127) * 8;
    float cw0[8], cw1[8], cw2[8];
    _Pragma("unroll") for (int j = 0; j < 8; ++j) { cw0[j] = p.conv_w[c0 + j]; cw1[j] = p.conv_w[1024 + c0 + j]; cw2[j] = p.conv_w[2048 + c0 + j]; }
    if (row < M_MAIN) {
        const int t = row & (SEQ - 1); float u0[8], u1[8], u2[8], w[8];
        unpack8(*(const uint4*)(UU(p) + (size_t)row * D + c0), u2);
        if (t >= 1) unpack8(*(const uint4*)(UU(p) + (size_t)(row - 1) * D + c0), u1); else _Pragma("unroll") for (int j = 0; j < 8; ++j) u1[j] = XA(p, X_U)[(size_t)(NDEC + 15) * D + c0 + j];
        if (t >= 2) unpack8(*(const uint4*)(UU(p) + (size_t)(row - 2) * D + c0), u0); else _Pragma("unroll") for (int j = 0; j < 8; ++j) u0[j] = XA(p, X_U)[(size_t)(NDEC + 14 + t) * D + c0 + j];
        bf16_t* a2 = A12(p) + (size_t)row * 2048 + 1024 + c0; unpack8(*(const uint4*)a2, w);
        _Pragma("unroll") for (int j = 0; j < 8; ++j) w[j] *= cw0[j] * u0[j] + cw1[j] * u1[j] + cw2[j] * u2[j];
        *(uint4*)a2 = pack8(w);
    } else if (row < M_MAIN + NDEC) {
        const int n = row - M_MAIN; const float* ctx = p.state_conv + (size_t)n * 2 * D; float* cs = p.out + O_CS + (size_t)n * 2 * D; float w[8];
        _Pragma("unroll") for (int j = 0; j < 8; ++j) { const float u = XA(p, X_U)[(size_t)n * D + c0 + j], c0v = ctx[c0 + j], c1v = ctx[D + c0 + j];
            w[j] = XA(p, X_W)[(size_t)n * D + c0 + j] * (cw0[j] * c0v + cw1[j] * c1v + cw2[j] * u); cs[c0 + j] = c1v; cs[D + c0 + j] = u; }
        *(uint4*)(A12X(p) + (size_t)n * 2048 + 1024 + c0) = pack8(w);
    }
}
__global__ void nk_p3a(Params p) {
    const size_t gid = (size_t)blockIdx.x * 256 + threadIdx.x;
    const int row = (int)(gid % (size_t)(M_MAIN + NDEC)), n0 = (int)(gid / (size_t)(M_MAIN + NDEC)) * 8;
    if (n0 >= D) return;
    const bool main = row < M_MAIN; const int e = row - M_MAIN;
    const uint4* a = (const uint4*)(main ? A12(p) + (size_t)row * 2048 : A12X(p) + (size_t)e * 2048);
    float ya[8], yb[8]; _Pragma("unroll") for (int j = 0; j < 8; ++j) { ya[j] = 0.f; yb[j] = 0.f; }
    for (int k8 = 0; k8 < 128; ++k8) {
        float a1[8], a2[8]; unpack8(a[k8], a1); unpack8(a[128 + k8], a2);
#pragma unroll
        for (int j = 0; j < 8; ++j) { float wv[8]; const uint4* w = (const uint4*)(WAB_T(p) + (size_t)(n0 + j) * 2048);
            unpack8(w[k8], wv); float s = 0.f;
#pragma unroll
            for (int q = 0; q < 8; ++q) s += a1[q] * wv[q];
            ya[j] += s; unpack8(w[128 + k8], wv); s = 0.f;
#pragma unroll
            for (int q = 0; q < 8; ++q) s += a2[q] * wv[q];
            yb[j] += s; }
    }
    float m[8];
    if (main) { float rt[8], gb[8]; unpack8(*(const uint4*)(RT(p) + (size_t)row * D + n0), rt); unpack8(*(const uint4*)(GB(p) + (size_t)row * D + n0), gb); _Pragma("unroll") for (int j = 0; j < 8; ++j) m[j] = gb[j] * (rt[j] * ya[j] + yb[j]);
        *(uint4*)(MG(p) + (size_t)row * D + n0) = pack8(m); }
    else { _Pragma("unroll") for (int j = 0; j < 8; ++j) m[j] = XA(p, X_GB)[(size_t)e * D + n0 + j] * (XA(p, X_RT)[(size_t)e * D + n0 + j] * ya[j] + yb[j]); *(uint4*)(MGX(p) + (size_t)e * D + n0) = pack8(m); }
}
__global__ void nk_p3b(Params p) {
    __shared__ float red[4];
    const int row = blockIdx.x, n0 = threadIdx.x * 4; const bool main = row < M_MAIN; const int e = row - M_MAIN;
    const uint4* a = (const uint4*)(main ? MG(p) + (size_t)row * D : MGX(p) + (size_t)e * D);
    float o[4] = {0.f, 0.f, 0.f, 0.f};
    for (int k8 = 0; k8 < 128; ++k8) { float av[8]; unpack8(a[k8], av);
#pragma unroll
        for (int j = 0; j < 4; ++j) { float wv[8]; unpack8(((const uint4*)(WO_T(p) + (size_t)(n0 + j) * D))[k8], wv); float s = 0.f;
#pragma unroll
            for (int q = 0; q < 8; ++q) s += av[q] * wv[q];
            o[j] += s; } }
    const float ss = block_sum256(o[0] * o[0] + o[1] * o[1] + o[2] * o[2] + o[3] * o[3], red);
    const float rs = rsqrtf(ss * (1.f / D) + EPS);
    const float* x = main ? p.x_prompt + (size_t)row * D : p.x_sample + (size_t)e * D; float* y = main ? p.out + O_YP + (size_t)row * D : p.out + O_YS + (size_t)e * D;
    _Pragma("unroll") for (int j = 0; j < 4; ++j) y[n0 + j] = x[n0 + j] + o[j] * rs * p.norm_post[n0 + j];
}

extern "C" void kernel_launch(void* const* d_in, const int* in_sizes, int n_in, void* d_out, int out_size, void* d_ws, size_t ws_size, hipStream_t stream) {
    static bool init = false;
    if (!init) { init = true; (void)hipFuncSetAttribute((const void*)nk_p2_scan, hipFuncAttributeMaxDynamicSharedMemorySize, 140 * 1024); }
    Params p{};
    p.x_prompt = (const float*)d_in[0]; p.x_sample = (const float*)d_in[1]; p.state_hgrn = (const float*)d_in[2]; p.state_conv = (const float*)d_in[3]; p.meta = (const float*)d_in[4];
    p.w_in = (const float*)d_in[5]; p.norm_pre = (const float*)d_in[6]; p.norm_post = (const float*)d_in[7]; p.lb_logits = (const float*)d_in[8]; p.hgrn_norm = (const float*)d_in[9];
    p.conv_w = (const float*)d_in[10]; p.w_a = (const float*)d_in[11]; p.w_b = (const float*)d_in[12]; p.w_o = (const float*)d_in[13];
    p.out = (float*)d_out; p.ws = (unsigned char*)d_ws;
    hipLaunchKernelGGL(nk_wconv, dim3(DIN + 2 * D), dim3(256), 0, stream, p);
    hipLaunchKernelGGL(nk_rmsnorm, dim3(M_MAIN + NXP), dim3(256), 0, stream, p);
    hipLaunchKernelGGL(nk_p1, dim3(NCHUNK + NXA / 32, 5 * 16), dim3(256), 0, stream, p);
    hipLaunchKernelGGL(nk_p2_scan, dim3(NB * NH), dim3(512), (128 * 128 + 4 * 32 * 128 + 32 * 33 + 128) * 4, stream, p);
    hipLaunchKernelGGL(nk_p2_decode, dim3(NDEC * NH), dim3(512), 0, stream, p);
    hipLaunchKernelGGL(nk_p2_conv, dim3((M_MAIN + NDEC) * 128 / 256), dim3(256), 0, stream, p);
    hipLaunchKernelGGL(nk_p3a, dim3((unsigned)(((size_t)(M_MAIN + NDEC) * 128 + 255) / 256)), dim3(256), 0, stream, p);
    hipLaunchKernelGGL(nk_p3b, dim3(M_MAIN + NDEC), dim3(256), 0, stream, p);
}
```

```cpp
#include <hip/hip_runtime.h>
#include <cstdint>
#include <cstdio>

typedef unsigned short bf16_t;
__device__ __forceinline__ int fresh_tid() { int t = threadIdx.x; asm volatile("" : "+v"(t)); return t; }

constexpr int D = 1024, NB = 8, SEQ = 2048, NDEC = 128, NMETA = 16, NH = 8, HD = 128, DIN = 10240;
constexpr int M_MAIN = NB * SEQ;
constexpr int NX = NDEC + NMETA;
constexpr int NXA = 160;
constexpr int NXP = 256;
constexpr int CHK = 32, NCHUNK = M_MAIN / CHK;
constexpr float EPS = 1e-6f;

constexpr size_t O_YP = 0, O_YS = 16777216, O_HP = O_YS + 131072, O_HS = O_HP + 1048576, O_CP = O_HS + 16777216, O_CS = O_CP + 16384;

constexpr size_t MiB = 1u << 20;
constexpr size_t WS_CTL = 0, WS_WIN = 1 * MiB, WS_WAB = 21 * MiB, WS_WO = 25 * MiB, WS_DL = 27 * MiB, WS_X = 30 * MiB;
constexpr size_t XSTRIDE = (size_t)NXA * D * 4;
constexpr size_t WS_A12X = 36 * MiB, WS_MGX = 37 * MiB;
constexpr size_t WS_QT = 38 * MiB, WS_KH = 70 * MiB, WS_V = 102 * MiB, WS_A12 = 134 * MiB, WS_U = 198 * MiB, WS_MG = WS_QT;
enum { X_Q = 0, X_K, X_F, X_V, X_SZA, X_W, X_U, X_RT, X_GB, X_N };

struct Params {
    const float *x_prompt, *x_sample, *state_hgrn, *state_conv, *meta, *w_in, *norm_pre, *norm_post, *lb_logits, *hgrn_norm, *conv_w, *w_a, *w_b, *w_o;
    float* out;
    unsigned char* ws;
};
__device__ __forceinline__ bf16_t* WIN_T(const Params& p) { return (bf16_t*)(p.ws + WS_WIN); }
__device__ __forceinline__ bf16_t* WAB_T(const Params& p) { return (bf16_t*)(p.ws + WS_WAB); }
__device__ __forceinline__ bf16_t* WO_T(const Params& p) { return (bf16_t*)(p.ws + WS_WO); }
__device__ __forceinline__ float* DLp(const Params& p) { return (float*)(p.ws + WS_DL); }
__device__ __forceinline__ float* XA(const Params& p, int i) { return (float*)(p.ws + WS_X + (size_t)i * XSTRIDE); }
__device__ __forceinline__ bf16_t* A12X(const Params& p) { return (bf16_t*)(p.ws + WS_A12X); }
__device__ __forceinline__ bf16_t* MGX(const Params& p) { return (bf16_t*)(p.ws + WS_MGX); }
__device__ __forceinline__ bf16_t* QT(const Params& p) { return (bf16_t*)(p.ws + WS_QT); }
__device__ __forceinline__ bf16_t* KH(const Params& p) { return (bf16_t*)(p.ws + WS_KH); }
__device__ __forceinline__ bf16_t* VV(const Params& p) { return (bf16_t*)(p.ws + WS_V); }
__device__ __forceinline__ bf16_t* A12(const Params& p) { return (bf16_t*)(p.ws + WS_A12); }
__device__ __forceinline__ bf16_t* UU(const Params& p) { return (bf16_t*)(p.ws + WS_U); }
__device__ __forceinline__ bf16_t* MG(const Params& p) { return (bf16_t*)(p.ws + WS_MG); }
__device__ __forceinline__ bf16_t* XN(const Params& p) { return (bf16_t*)(p.out + O_HS); }
__device__ __forceinline__ bf16_t* RT(const Params& p) { return (bf16_t*)(p.out + O_YP); }
__device__ __forceinline__ bf16_t* GB(const Params& p) { return (bf16_t*)(p.out + O_YP) + (size_t)M_MAIN * D; }

__device__ __forceinline__ float bf2f(bf16_t h) { return __uint_as_float(((unsigned)h) << 16); }
__device__ __forceinline__ bf16_t f2bf(float f) { unsigned u = __float_as_uint(f); return (bf16_t)((u + 0x7fffu + ((u >> 16) & 1u)) >> 16); }
__device__ __forceinline__ float clampf(float x, float lo, float hi) { return fminf(fmaxf(x, lo), hi); }
__device__ __forceinline__ float sigm(float x) { return 1.f / (1.f + __expf(-clampf(x, -30.f, 30.f))); }
__device__ __forceinline__ float silu(float x) { return x * sigm(x); }
__device__ __forceinline__ void unpack8(uint4 v, float* f) {
    f[0] = __uint_as_float(v.x << 16); f[1] = __uint_as_float(v.x & 0xffff0000u); f[2] = __uint_as_float(v.y << 16); f[3] = __uint_as_float(v.y & 0xffff0000u);
    f[4] = __uint_as_float(v.z << 16); f[5] = __uint_as_float(v.z & 0xffff0000u); f[6] = __uint_as_float(v.w << 16); f[7] = __uint_as_float(v.w & 0xffff0000u);
}
__device__ __forceinline__ uint4 pack8(const float* f) {
    uint4 v; v.x = f2bf(f[0]) | ((unsigned)f2bf(f[1]) << 16); v.y = f2bf(f[2]) | ((unsigned)f2bf(f[3]) << 16);
    v.z = f2bf(f[4]) | ((unsigned)f2bf(f[5]) << 16); v.w = f2bf(f[6]) | ((unsigned)f2bf(f[7]) << 16); return v;
}
__host__ __device__ __forceinline__ int srccol(int n) {
    const int pn = n >> 8, bj = (n >> 7) & 1, j = n & 127, T = pn >> 3, cb = pn & 7;
    const int split = ((bj ? 0x96731 : 0x85420) >> (4 * T)) & 15;
    return split * 1024 + cb * 128 + j;
}
__device__ __forceinline__ int nrow_x(int T, int c) { return 256 * (T * 8 + (c >> 7)) + (c & 127); }
__device__ __forceinline__ float lbound(const Params& p, int c) { return 1.f / (1.f + __expf(p.lb_logits[1024 + c] - p.lb_logits[c])); }


namespace pg8 {
#define PG8_LAS __attribute__((address_space(3)))
typedef unsigned short bf16_t;
typedef short bf16x8 __attribute__((ext_vector_type(8)));
typedef float f32x4 __attribute__((ext_vector_type(4)));
typedef unsigned u32x4 __attribute__((ext_vector_type(4)));
constexpr int BM = 256, BK = 64, HALF = 128, HTB = HALF * BK * 2  , STAGE_BYTES = 8 * HTB, NXCD = 8, WGM = 8;

__host__ __device__ __forceinline__ int lds_byte(int r, int c) { const int st = (r >> 4) * 2 + (c >> 5), rr = r & 15, cc = c & 31, ob = rr * 64 + cc * 2; return st * 1024 + (ob ^ (((ob >> 9) & 1) << 5)); }
__host__ __device__ __forceinline__ void stage_rc(int b, int& R, int& C) { const int st = b / 1024, sb = b % 1024, swz = sb ^ (((sb >> 9) & 1) << 5); R = (st >> 1) * 16 + swz / 64; C = (st & 1) * 32 + (swz % 64) / 2; }
__host__ __device__ __forceinline__ int perm32(int rho) { const int n = rho >> 4, i = rho & 15; return 8 * (i >> 2) + 4 * n + (i & 3); }

struct Unit { int pm, pn; };
struct Gemm { const bf16_t* A; const bf16_t* Bt; int M, N, K; };

struct StaticOrder {
    int nM, nN, nwg, G, c;
    __host__ __device__ void init(int M, int N, int G_, int c_) { nM = M / BM; nN = N / BM; nwg = nM * nN; G = G_; c = c_; }
    __host__ __device__ bool next(int i, Unit& u) const {
        const long L = (long)i * G + c; if (L >= nwg) return false;
        int wgid = (int)L; { const int q = nwg / NXCD, r = nwg % NXCD, xcd = wgid % NXCD, off = wgid / NXCD; wgid = (xcd < r ? xcd * (q + 1) : r * (q + 1) + (xcd - r) * q) + off; }
        const int nig = WGM * nN, gid = wgid / nig, fm = gid * WGM, gsz = (nM - fm) < WGM ? (nM - fm) : WGM;
        u.pm = fm + ((wgid % nig) % gsz); u.pn = (wgid % nig) / gsz; return true;
    }
    __device__ __forceinline__ void a_ready(const Unit&) const {}
    __device__ __forceinline__ void done(const Unit&) const {}
};


template <class Epi, class Sched, bool ALIGN_EPI = false, bool SP2 = false, bool MIDK = false>
__device__ __forceinline__ void gemm_phase(PG8_LAS unsigned char* lds, const Gemm g, const Sched& S, const Epi& E) {
    const int tid = fresh_tid(), wid = __builtin_amdgcn_readfirstlane(tid >> 6), lane = tid & 63, wr = wid >> 2, wc = wid & 3, fr = lane & 15, fq = lane >> 4;
    const int K = g.K, nt = K / BK;
    unsigned voffA[2], voffB[2];
#pragma unroll
    for (int i = 0; i < 2; ++i) { int R, C; stage_rc(tid * 16 + i * 8192, R, C); const int Rb = Epi::PERM ? ((R & ~31) + perm32(R & 31)) : R;
        voffA[i] = (unsigned)(R * K + C) * 2u; voffB[i] = (unsigned)(Rb * K + C) * 2u; }
    const size_t kstep = (size_t)(BK * 2);
    const size_t hstep = (size_t)HALF * K * 2;
    const size_t tstep = 2 * hstep;
    const unsigned ldsw = (unsigned)wid * 1024u;
    const int aoff = lds_byte(wr * 64 + fr, fq * 8), boff = lds_byte(wc * 32 + fr, fq * 8);
#define PG8_SA(b, h) (((b) * 2 + (h)) * HTB)
#define PG8_SB(b, h) ((4 + (b) * 2 + (h)) * HTB)
#define PG8_STAGE(bufoff, gbase, voff) do { _Pragma("unroll") for (int _i = 0; _i < 2; ++_i) \
        __builtin_amdgcn_global_load_lds((const unsigned*)((const char*)(gbase) + (voff)[_i]), (PG8_LAS unsigned*)(lds + (bufoff) + ldsw + _i * 8192), 16, 0, 0); } while (0)
#define PG8_LDA(dst, b, h) do { _Pragma("unroll") for (int m = 0; m < 4; ++m) _Pragma("unroll") for (int k = 0; k < 2; ++k) dst[m][k] = *(const PG8_LAS bf16x8*)(lds + PG8_SA(b, h) + aoff + m * 2048 + k * 1024); } while (0)
#define PG8_LDB(dst, b, h) do { _Pragma("unroll") for (int n = 0; n < 2; ++n) _Pragma("unroll") for (int k = 0; k < 2; ++k) dst[n][k] = *(const PG8_LAS bf16x8*)(lds + PG8_SB(b, h) + boff + n * 2048 + k * 1024); } while (0)
#define PG8_MMA(ai, bj, At, Bt) do { __builtin_amdgcn_s_setprio(1); _Pragma("unroll") for (int m = 0; m < 4; ++m) _Pragma("unroll") for (int n = 0; n < 2; ++n) _Pragma("unroll") for (int k = 0; k < 2; ++k) \
        acc[ai][bj][m][n] = __builtin_amdgcn_mfma_f32_16x16x32_bf16(Bt[n][k], At[m][k], acc[ai][bj][m][n], 0, 0, 0); __builtin_amdgcn_s_setprio(0); } while (0)
#define PG8_WAIT_V(n) asm volatile("s_waitcnt vmcnt(" #n ")" ::: "memory")
#define PG8_WAIT_L(n) asm volatile("s_waitcnt lgkmcnt(" #n ")" ::: "memory")
#define PG8_BAR __builtin_amdgcn_s_barrier()
#define PG8_SCHED __builtin_amdgcn_sched_barrier(0)
    Unit cur, nxt; int ui = 0;
    if (!S.next(0, cur)) return;
    f32x4 acc[2][2][4][2];
#pragma unroll
    for (int a = 0; a < 2; ++a)
#pragma unroll
        for (int b = 0; b < 2; ++b)
#pragma unroll
            for (int m = 0; m < 4; ++m)
#pragma unroll
                for (int n = 0; n < 2; ++n) acc[a][b][m][n] = (f32x4){0.f, 0.f, 0.f, 0.f};
    bf16x8 At[4][2], B0[2][2], B1[2][2];
    const char* cA = (const char*)g.A + (size_t)cur.pm * tstep; const char* cB = (const char*)g.Bt + (size_t)cur.pn * tstep;
    S.a_ready(cur);
    if constexpr (SP2) {
        PG8_STAGE(PG8_SB(0, 0), cB, voffB); PG8_STAGE(PG8_SB(0, 1), cB + hstep, voffB); PG8_STAGE(PG8_SA(0, 0), cA, voffA); PG8_STAGE(PG8_SA(0, 1), cA + hstep, voffA);
        if (wr == 1) PG8_BAR;
        PG8_WAIT_V(2); PG8_BAR;
        PG8_STAGE(PG8_SB(1, 0), cB + kstep, voffB); PG8_STAGE(PG8_SA(1, 0), cA + kstep, voffA); PG8_STAGE(PG8_SB(1, 1), cB + hstep + kstep, voffB);
        PG8_WAIT_V(6); PG8_BAR;
    } else {
        PG8_STAGE(PG8_SB(0, 0), cB, voffB); PG8_STAGE(PG8_SA(0, 0), cA, voffA); PG8_STAGE(PG8_SB(0, 1), cB + hstep, voffB); PG8_STAGE(PG8_SA(0, 1), cA + hstep, voffA);
        if (wr == 1) PG8_BAR;
        PG8_WAIT_V(4); PG8_BAR;
        PG8_STAGE(PG8_SB(1, 0), cB + kstep, voffB); PG8_STAGE(PG8_SA(1, 0), cA + kstep, voffA); PG8_STAGE(PG8_SB(1, 1), cB + hstep + kstep, voffB);
        PG8_WAIT_V(6); PG8_BAR;
    }
    for (;;) {
        const bool has_next = S.next(ui + 1, nxt);
        const char* nA = has_next ? (const char*)g.A + (size_t)nxt.pm * tstep : cA; const char* nB = has_next ? (const char*)g.Bt + (size_t)nxt.pn * tstep : cB;
        for (int t = 0; t < nt; t += 2) {
            const bool last = (t == nt - 2);
            const char* a1 = cA + (size_t)(t + 1) * kstep;
            const char* a2 = last ? nA : cA + (size_t)(t + 2) * kstep; const char* b2 = last ? nB : cB + (size_t)(t + 2) * kstep;
            const char* a3 = a2 + kstep; const char* b3 = b2 + kstep;
            if (last && has_next) S.a_ready(nxt);
            if constexpr (MIDK) { if (t == nt / 2) E.mid(acc, cur, wr, wc, fr, fq); }
            if constexpr (SP2) {
            PG8_LDB(B0, 0, 0); PG8_LDB(B1, 0, 1); PG8_SCHED; PG8_LDA(At, 0, 0); PG8_STAGE(PG8_SA(1, 1), a1 + hstep, voffA);
            PG8_WAIT_V(8); PG8_WAIT_L(0); PG8_BAR; PG8_MMA(0, 0, At, B0); PG8_MMA(0, 1, At, B1); PG8_BAR; PG8_SCHED;
            PG8_LDA(At, 0, 1); PG8_STAGE(PG8_SB(0, 0), b2, voffB); PG8_STAGE(PG8_SB(0, 1), b2 + hstep, voffB); PG8_STAGE(PG8_SA(0, 0), a2, voffA);
            PG8_WAIT_V(8); PG8_WAIT_L(0); PG8_BAR; PG8_MMA(1, 0, At, B0); PG8_MMA(1, 1, At, B1); PG8_BAR; PG8_SCHED;
            PG8_LDB(B0, 1, 0); PG8_LDB(B1, 1, 1); PG8_SCHED; PG8_LDA(At, 1, 0); PG8_STAGE(PG8_SA(0, 1), a2 + hstep, voffA);
            PG8_WAIT_V(8); PG8_WAIT_L(0); PG8_BAR; PG8_MMA(0, 0, At, B0); PG8_MMA(0, 1, At, B1); PG8_BAR; PG8_SCHED;
            PG8_LDA(At, 1, 1); PG8_STAGE(PG8_SB(1, 0), b3, voffB); PG8_STAGE(PG8_SB(1, 1), b3 + hstep, voffB); PG8_STAGE(PG8_SA(1, 0), a3, voffA);
            PG8_WAIT_V(8); PG8_WAIT_L(0); PG8_BAR; PG8_MMA(1, 0, At, B0); PG8_MMA(1, 1, At, B1); PG8_BAR; PG8_SCHED;
            } else {
            PG8_LDB(B0, 0, 0); PG8_SCHED; PG8_LDA(At, 0, 0); PG8_STAGE(PG8_SA(1, 1), a1 + hstep, voffA);
            PG8_WAIT_L(8); PG8_BAR; PG8_WAIT_L(0); PG8_MMA(0, 0, At, B0); PG8_BAR; PG8_SCHED;
            PG8_LDB(B1, 0, 1); PG8_STAGE(PG8_SB(0, 0), b2, voffB);
            PG8_BAR; PG8_WAIT_L(0); PG8_MMA(0, 1, At, B1); PG8_BAR;
            PG8_LDA(At, 0, 1); PG8_STAGE(PG8_SA(0, 0), a2, voffA);
            PG8_BAR; PG8_WAIT_L(0); PG8_MMA(1, 0, At, B0); PG8_BAR; PG8_SCHED;
            PG8_STAGE(PG8_SB(0, 1), b2 + hstep, voffB);
            PG8_WAIT_V(6); PG8_BAR; PG8_MMA(1, 1, At, B1); PG8_BAR;
            PG8_LDB(B0, 1, 0); PG8_SCHED; PG8_LDA(At, 1, 0); PG8_STAGE(PG8_SA(0, 1), a2 + hstep, voffA);
            PG8_WAIT_L(8); PG8_BAR; PG8_WAIT_L(0); PG8_MMA(0, 0, At, B0); PG8_BAR; PG8_SCHED;
            PG8_LDB(B1, 1, 1); PG8_STAGE(PG8_SB(1, 0), b3, voffB);
            PG8_BAR; PG8_WAIT_L(0); PG8_MMA(0, 1, At, B1); PG8_BAR;
            PG8_LDA(At, 1, 1); PG8_STAGE(PG8_SA(1, 0), a3, voffA);
            PG8_BAR; PG8_WAIT_L(0); PG8_MMA(1, 0, At, B0); PG8_BAR; PG8_SCHED;
            PG8_STAGE(PG8_SB(1, 1), b3 + hstep, voffB);
            PG8_WAIT_V(6); PG8_BAR; PG8_MMA(1, 1, At, B1); PG8_BAR;
            }
        }
        if constexpr (ALIGN_EPI) { if (wr == 0) PG8_BAR; }
        if constexpr (!Epi::AFTER_DRAIN) { E(acc, cur, wr, wc, fr, fq); S.done(cur); }
        if (!has_next) break;
#pragma unroll
        for (int a = 0; a < 2; ++a)
#pragma unroll
            for (int b = 0; b < 2; ++b)
#pragma unroll
                for (int m = 0; m < 4; ++m)
#pragma unroll
                    for (int n = 0; n < 2; ++n) acc[a][b][m][n] = (f32x4){0.f, 0.f, 0.f, 0.f};
        cur = nxt; cA = nA; cB = nB; ++ui;
        if constexpr (ALIGN_EPI) { if (wr == 1) PG8_BAR; }
    }
    PG8_WAIT_V(0);
    if constexpr (!ALIGN_EPI) { if (wr == 0) PG8_BAR; }
    PG8_BAR;
    if constexpr (Epi::AFTER_DRAIN) { E.fused(acc, cur, wr, wc, fr, fq, lds, wid, lane); S.done(cur); }
#undef PG8_SA
#undef PG8_SB
#undef PG8_STAGE
#undef PG8_LDA
#undef PG8_LDB
#undef PG8_MMA
#undef PG8_WAIT_V
#undef PG8_WAIT_L
#undef PG8_BAR
#undef PG8_SCHED
}
}

#define LAS __attribute__((address_space(3)))
typedef float f32x4 __attribute__((ext_vector_type(4)));
typedef float f32x2_t __attribute__((ext_vector_type(2)));
typedef __bf16 bf16x2_t __attribute__((ext_vector_type(2)));
typedef short bf16x8 __attribute__((ext_vector_type(8)));
__device__ __forceinline__ unsigned cvtpk(float lo, float hi) { f32x2_t v = {lo, hi}; bf16x2_t b = __builtin_convertvector(v, bf16x2_t); return __builtin_bit_cast(unsigned, b); }
__device__ __forceinline__ uint4 pack8v(f32x4 a, f32x4 b) { uint4 v; v.x = cvtpk(a[0], a[1]); v.y = cvtpk(a[2], a[3]); v.z = cvtpk(b[0], b[1]); v.w = cvtpk(b[2], b[3]); return v; }
__device__ __forceinline__ void unpack8v(uint4 v, f32x4& a, f32x4& b) {
    a[0] = __uint_as_float(v.x << 16); a[1] = __uint_as_float(v.x & 0xffff0000u); a[2] = __uint_as_float(v.y << 16); a[3] = __uint_as_float(v.y & 0xffff0000u);
    b[0] = __uint_as_float(v.z << 16); b[1] = __uint_as_float(v.z & 0xffff0000u); b[2] = __uint_as_float(v.w << 16); b[3] = __uint_as_float(v.w & 0xffff0000u);
}
__device__ __forceinline__ float fexp(float x) { return __expf(x); }
__device__ __forceinline__ float frcp(float x) { return __builtin_amdgcn_rcpf(x); }
template <int CTRL> __device__ __forceinline__ float dppf(float v) { return __int_as_float(__builtin_amdgcn_update_dpp(0, __float_as_int(v), CTRL, 0xf, 0xf, false)); }
__device__ __forceinline__ float scan16(float x) {
    x += dppf<0x111>(x); x += dppf<0x112>(x); x += dppf<0x114>(x); x += dppf<0x118>(x); return x;
}
__device__ __forceinline__ float wave_sum(float v) {
#pragma unroll
    for (int o = 1; o < 64; o <<= 1) v += __shfl_xor(v, o);
    return v;
}

struct EpiP1 {
    static constexpr bool PERM = true, AFTER_DRAIN = false;
    Params p;
    __device__ __forceinline__ void operator()(const f32x4 (&acc)[2][2][4][2], const pg8::Unit& u, int wr, int wc, int fr, int fq) const {
        const int T = u.pn >> 3;
        const int c0 = (u.pn & 7) * 128 + wc * 32 + fq * 8;
        const int rbase = u.pm * 256 + wr * 64 + fr;
        if (T == 0) {
#pragma unroll
            for (int ai = 0; ai < 2; ++ai)
#pragma unroll
                for (int mp = 0; mp < 2; ++mp) {
                    uint2 qtp[2][2], khp[2][2];
                    f32x4 dlv[2];
#pragma unroll
                    for (int n = 0; n < 2; ++n) {
                        f32x4 lb, om, qa[2], kk[2], G[2];
#pragma unroll
                        for (int e = 0; e < 4; ++e) { lb[e] = lbound(p, c0 + 4 * n + e); om[e] = 1.f - lb[e]; }
#pragma unroll
                        for (int hf = 0; hf < 2; ++hf)
#pragma unroll
                            for (int e = 0; e < 4; ++e) {
                                const float x = acc[ai][0][2 * mp + hf][n][e], y = acc[ai][1][2 * mp + hf][n][e];
                                const float ee = fexp(-clampf(y, -30.f, 30.f)), sg = frcp(1.f + ee);
                                qa[hf][e] = x * frcp(1.f + fexp(-clampf(x, -30.f, 30.f)));
                                kk[hf][e] = om[e] * ee * sg;
                                G[hf][e] = __logf(lb[e] + om[e] * sg);
                            }
#pragma unroll
                        for (int e = 0; e < 4; ++e) {
                            const float s0 = scan16(G[0][e]);
                            const float t0 = __shfl(s0, (int)((threadIdx.x & 48) | 15));
                            G[0][e] = s0; G[1][e] = scan16(G[1][e]) + t0;
                        }
#pragma unroll
                        for (int hf = 0; hf < 2; ++hf) {
                            f32x4 qt, kh;
#pragma unroll
                            for (int e = 0; e < 4; ++e) { const float eg = fexp(fmaxf(G[hf][e], -80.f)); qt[e] = qa[hf][e] * eg; kh[e] = kk[hf][e] * frcp(eg); }
                            qtp[hf][n] = make_uint2(cvtpk(qt[0], qt[1]), cvtpk(qt[2], qt[3])); khp[hf][n] = make_uint2(cvtpk(kh[0], kh[1]), cvtpk(kh[2], kh[3]));
                        }
#pragma unroll
                        for (int e = 0; e < 4; ++e) dlv[n][e] = fexp(G[1][e]);
                    }
#pragma unroll
                    for (int hf = 0; hf < 2; ++hf) {
                        const size_t o = (size_t)(rbase + 128 * ai + 32 * mp + 16 * hf) * D + c0;
                        *(uint4*)(QT(p) + o) = make_uint4(qtp[hf][0].x, qtp[hf][0].y, qtp[hf][1].x, qtp[hf][1].y);
                        *(uint4*)(KH(p) + o) = make_uint4(khp[hf][0].x, khp[hf][0].y, khp[hf][1].x, khp[hf][1].y);
                    }
                    if (fr == 15) {
                        const int chunk = (u.pm * 256 + 128 * ai + 64 * wr + 32 * mp) >> 5;
                        float* dp = DLp(p) + (size_t)chunk * D + c0; *(f32x4*)dp = dlv[0]; *(f32x4*)(dp + 4) = dlv[1];
                    }
                }
            return;
        }
#pragma unroll
        for (int ai = 0; ai < 2; ++ai)
#pragma unroll
            for (int m = 0; m < 4; ++m) {
                const int row = rbase + 128 * ai + 16 * m;
                const f32x4 x0 = acc[ai][0][m][0], x1 = acc[ai][0][m][1], y0 = acc[ai][1][m][0], y1 = acc[ai][1][m][1];
                f32x4 r0, r1, s0, s1;
                if (T == 1) {
#pragma unroll
                    for (int e = 0; e < 4; ++e) { s0[e] = y0[e] * frcp(1.f + fexp(-clampf(y0[e], -30.f, 30.f))); s1[e] = y1[e] * frcp(1.f + fexp(-clampf(y1[e], -30.f, 30.f))); }
                    *(uint4*)(VV(p) + (size_t)row * D + c0) = pack8v(x0, x1);
                    *(uint4*)(A12(p) + (size_t)row * 2048 + c0) = pack8v(s0, s1);
                } else if (T == 2) {
#pragma unroll
                    for (int e = 0; e < 4; ++e) { r0[e] = x0[e] * y0[e] * frcp(1.f + fexp(-clampf(y0[e], -30.f, 30.f))); r1[e] = x1[e] * y1[e] * frcp(1.f + fexp(-clampf(y1[e], -30.f, 30.f))); }
                    *(uint4*)(A12(p) + (size_t)row * 2048 + 1024 + c0) = pack8v(r0, r1);
                } else if (T == 3) {
                    r0 = x0 * y0; r1 = x1 * y1;
                    *(uint4*)(UU(p) + (size_t)row * D + c0) = pack8v(r0, r1);
                    const int t = row & (SEQ - 1);
                    if (t >= SEQ - 2) { float* cp = p.out + O_CP + ((size_t)(row >> 11) * 2 + (t - (SEQ - 2))) * D + c0; *(f32x4*)cp = r0; *(f32x4*)(cp + 4) = r1; }
                } else {
#pragma unroll
                    for (int e = 0; e < 4; ++e) {
                        const float ea0 = fexp(-clampf(x0[e], -30.f, 30.f)), eb0 = fexp(-clampf(y0[e], -30.f, 30.f)), ea1 = fexp(-clampf(x1[e], -30.f, 30.f)), eb1 = fexp(-clampf(y1[e], -30.f, 30.f));
                        r0[e] = (1.f + eb0) * frcp(1.f + ea0); r1[e] = (1.f + eb1) * frcp(1.f + ea1); s0[e] = frcp(1.f + eb0); s1[e] = frcp(1.f + eb1);
                    }
                    *(uint4*)(RT(p) + (size_t)row * D + c0) = pack8v(r0, r1);
                    *(uint4*)(GB(p) + (size_t)row * D + c0) = pack8v(s0, s1);
                }
            }
    }
};
struct EpiMG {
    static constexpr bool PERM = true, AFTER_DRAIN = false;
    Params p;
    __device__ __forceinline__ void mid(f32x4 (&acc)[2][2][4][2], const pg8::Unit& u, int wr, int wc, int fr, int fq) const {
        int rbase = u.pm * 256 + wr * 64 + fr, cb = u.pn * 256 + wc * 32 + fq * 8; asm volatile("" : "+v"(rbase), "+v"(cb));
#pragma unroll
        for (int ai = 0; ai < 2; ++ai)
#pragma unroll
            for (int m = 0; m < 4; ++m)
#pragma unroll
                for (int bj = 0; bj < 2; ++bj) { f32x4 a, b; unpack8v(*(const uint4*)(RT(p) + (size_t)(rbase + 128 * ai + 16 * m) * D + cb + 128 * bj), a, b); acc[ai][bj][m][0] *= a; acc[ai][bj][m][1] *= b; }
    }
    __device__ __forceinline__ void operator()(const f32x4 (&acc)[2][2][4][2], const pg8::Unit& u, int wr, int wc, int fr, int fq) const {
        int rbase = u.pm * 256 + wr * 64 + fr, cb = u.pn * 256 + wc * 32 + fq * 8; asm volatile("" : "+v"(rbase), "+v"(cb));
#pragma unroll
        for (int ai = 0; ai < 2; ++ai)
#pragma unroll
            for (int m = 0; m < 4; ++m)
#pragma unroll
                for (int bj = 0; bj < 2; ++bj) { const size_t o = (size_t)(rbase + 128 * ai + 16 * m) * D + cb + 128 * bj; f32x4 a, b; unpack8v(*(const uint4*)(GB(p) + o), a, b);
                    *(uint4*)(MG(p) + o) = pack8v(acc[ai][bj][m][0] * a, acc[ai][bj][m][1] * b); }
    }
};
struct EpiOut {
    static constexpr bool PERM = false, AFTER_DRAIN = false;
    float* C;
    __device__ __forceinline__ void operator()(const f32x4 (&acc)[2][2][4][2], const pg8::Unit& u, int wr, int wc, int fr, int fq) const {
        const int row0 = u.pm * 256 + wr * 64 + fr, col0 = u.pn * 256 + wc * 32 + 4 * fq;
#pragma unroll
        for (int ai = 0; ai < 2; ++ai)
#pragma unroll
            for (int m = 0; m < 4; ++m) { float* rowp = C + (size_t)(row0 + ai * 128 + m * 16) * D + col0;
#pragma unroll
                for (int bj = 0; bj < 2; ++bj)
#pragma unroll
                    for (int n = 0; n < 2; ++n) *(f32x4*)(rowp + bj * 128 + n * 16) = acc[ai][bj][m][n]; }
    }
};

constexpr int TG_BROW = 2048 + 16;
template <bool DUAL, class F>
__device__ __forceinline__ void tail_unit(LAS unsigned char* lds, const bf16_t* A, int lda, int aoff_y, int nrb, const bf16_t* Bx, const bf16_t* By, int ldb, const F& f) {
    const int tid = fresh_tid(), lane = tid & 63, wid = tid >> 6, fr = lane & 15, fq = lane >> 4;
    __syncthreads();
#pragma unroll
    for (int i = 0; i < 4; ++i) { const int idx = tid + 512 * i, r = idx >> 7, ch = idx & 127;
        *(LAS bf16x8*)(lds + r * TG_BROW + ch * 16) = *(const bf16x8*)(Bx + (size_t)r * ldb + ch * 8);
        if (DUAL) *(LAS bf16x8*)(lds + 16 * TG_BROW + r * TG_BROW + ch * 16) = *(const bf16x8*)(By + (size_t)r * ldb + ch * 8); }
    __syncthreads();
    for (int rb = wid; rb < nrb; rb += 8) {
        f32x4 ax = {0.f, 0.f, 0.f, 0.f}, ay = {0.f, 0.f, 0.f, 0.f};
        const bf16_t* arow = A + (size_t)(rb * 16 + fr) * lda + fq * 8;
#pragma unroll 8
        for (int ks = 0; ks < 32; ++ks) {
            const bf16x8 af = *(const bf16x8*)(arow + ks * 32);
            const bf16x8 bx = *(const LAS bf16x8*)(lds + fr * TG_BROW + ks * 64 + fq * 16);
            ax = __builtin_amdgcn_mfma_f32_16x16x32_bf16(bx, af, ax, 0, 0, 0);
            if (DUAL) { const bf16x8 af2 = *(const bf16x8*)(arow + aoff_y + ks * 32); const bf16x8 by = *(const LAS bf16x8*)(lds + 16 * TG_BROW + fr * TG_BROW + ks * 64 + fq * 16);
                ay = __builtin_amdgcn_mfma_f32_16x16x32_bf16(by, af2, ay, 0, 0, 0); }
        }
        f(rb * 16 + fr, 4 * fq, ax, ay);
    }
}

__device__ __forceinline__ void p0_transpose_item(const float* W, int ldw, int srccol0, bf16_t* WT, int ldt, int dstrow0, int dstcol0, int k0, LAS float* scr, int lane) {
#pragma unroll 8
    for (int i = 0; i < 32; ++i) { const int kk = 2 * i + (lane >> 5); scr[kk * 33 + (lane & 31)] = W[(size_t)(k0 + kk) * ldw + srccol0 + (lane & 31)]; }
    asm volatile("s_waitcnt lgkmcnt(0)" ::: "memory");
    const int c = lane & 7;
#pragma unroll
    for (int j = 0; j < 4; ++j) { const int n = (lane >> 3) + 8 * j; const LAS float* s = scr + (8 * c) * 33 + n;
        uint4 o; o.x = cvtpk(s[0 * 33], s[1 * 33]); o.y = cvtpk(s[2 * 33], s[3 * 33]); o.z = cvtpk(s[4 * 33], s[5 * 33]); o.w = cvtpk(s[6 * 33], s[7 * 33]);
        *(uint4*)(WT + (size_t)(dstrow0 + n) * ldt + dstcol0 + k0 + 8 * c) = o; }
    asm volatile("s_waitcnt lgkmcnt(0)" ::: "memory");
}
__device__ __forceinline__ void p0_phase(const Params& p, LAS unsigned char* lds, int vcu, int G) {
    const int tid = fresh_tid(), lane = tid & 63, wid = tid >> 6;
    LAS float* scr = (LAS float*)(lds + wid * 16384);
    const int gw = vcu * 8 + wid, NGW = G * 8;
    constexpr int I_IN = 16 * 320, I_SQ = 16 * 32, NITEMS = I_IN + 3 * I_SQ;
    for (int it = gw; it < NITEMS; it += NGW) {
        int r = it;
        if (r < I_IN) { const int kb = r / 320, nb = r % 320; p0_transpose_item(p.w_in, DIN, srccol(32 * nb), WIN_T(p), D, 32 * nb, 0, 64 * kb, scr, lane); continue; } r -= I_IN;
        const int kb = (r % I_SQ) / 32, nb = r % 32;
        if (r < I_SQ) p0_transpose_item(p.w_a, D, 32 * nb, WAB_T(p), 2048, 32 * nb, 0, 64 * kb, scr, lane);
        else if (r < 2 * I_SQ) p0_transpose_item(p.w_b, D, 32 * nb, WAB_T(p), 2048, 32 * nb, 1024, 64 * kb, scr, lane);
        else p0_transpose_item(p.w_o, D, 32 * nb, WO_T(p), D, 32 * nb, 0, 64 * kb, scr, lane);
    }
    for (int r = gw; r < M_MAIN + NXP; r += NGW) {
        uint2* o = (uint2*)(XN(p) + (size_t)r * D) + lane;
        const float* src = nullptr;
        if (r < M_MAIN) src = p.x_prompt + (size_t)r * D; else if (r < M_MAIN + NDEC) src = p.x_sample + (size_t)(r - M_MAIN) * D; else if (r < M_MAIN + NX) src = p.meta + (size_t)(r - M_MAIN - NDEC) * D;
        if (!src) { for (int j = 0; j < 4; ++j) o[64 * j] = make_uint2(0u, 0u); continue; }
        f32x4 v[4]; float s = 0.f;
#pragma unroll
        for (int j = 0; j < 4; ++j) { v[j] = ((const f32x4*)src)[lane + 64 * j]; s += (v[j][0] * v[j][0] + v[j][1] * v[j][1]) + (v[j][2] * v[j][2] + v[j][3] * v[j][3]); }
        const float rs = rsqrtf(wave_sum(s) * (1.f / D) + EPS);
#pragma unroll
        for (int j = 0; j < 4; ++j) { const f32x4 w = ((const f32x4*)p.norm_pre)[lane + 64 * j]; o[64 * j] = make_uint2(cvtpk(v[j][0] * rs * w[0], v[j][1] * rs * w[1]), cvtpk(v[j][2] * rs * w[2], v[j][3] * rs * w[3])); }
    }
}

__device__ __forceinline__ void extras_store(const Params& p, int T, int e, int c, float x, float y) {
    const size_t o = (size_t)e * D + c;
    if (T == 0) { const float lb = lbound(p, c); const float ee = __expf(-clampf(y, -30.f, 30.f)), sg = 1.f / (1.f + ee);
        XA(p, X_Q)[o] = silu(x); XA(p, X_F)[o] = lb + (1.f - lb) * sg; XA(p, X_K)[o] = (1.f - lb) * ee * sg; }
    else if (T == 1) { XA(p, X_V)[o] = x; XA(p, X_SZA)[o] = silu(y); }
    else if (T == 2) { XA(p, X_W)[o] = x * silu(y); }
    else if (T == 3) { XA(p, X_U)[o] = x * y; }
    else { const float ga = sigm(x), gb = sigm(y); XA(p, X_RT)[o] = ga / gb; XA(p, X_GB)[o] = gb; }
}
__device__ __forceinline__ void p1_extras(const Params& p, LAS unsigned char* lds, int vcu, int G) {
    for (int u = vcu; u < 320; u += G) {
        const int T = u / 64, c0 = (u % 64) * 16;
        const bf16_t* bx = WIN_T(p) + (size_t)nrow_x(T, c0) * D;
        auto f = [&](int row, int col, const f32x4& ax, const f32x4& ay) {
            if (row < NX) {
#pragma unroll
                for (int e = 0; e < 4; ++e) extras_store(p, T, row, c0 + col + e, ax[e], ay[e]); } };
        tail_unit<true>(lds, XN(p) + (size_t)M_MAIN * D, D, 0, 9, bx, bx + (size_t)128 * D, D, f);
    }
}
__device__ __forceinline__ void p3a_extras(const Params& p, LAS unsigned char* lds, int vcu, int G) {
    for (int u = vcu; u < 64; u += G) {
        const int n0 = u * 16;
        auto f = [&](int row, int col, const f32x4& ax, const f32x4& ay) {
            const size_t o = (size_t)row * D + n0 + col; const f32x4 rt = *(const f32x4*)(XA(p, X_RT) + o), gb = *(const f32x4*)(XA(p, X_GB) + o);
            const f32x4 m = gb * (rt * ax + ay); *(uint2*)(MGX(p) + o) = make_uint2(cvtpk(m[0], m[1]), cvtpk(m[2], m[3])); };
        tail_unit<true>(lds, A12X(p), 2048, 1024, 8, WAB_T(p) + (size_t)n0 * 2048, WAB_T(p) + (size_t)n0 * 2048 + 1024, 2048, f);
    }
}
__device__ __forceinline__ float* OUTX(const Params& p) { return (float*)(p.ws + WS_MGX + (MiB >> 1)); }
__device__ __forceinline__ float* OUTM(const Params& p) { return (float*)(p.ws + WS_A12); }
__device__ __forceinline__ void p3b_extras(const Params& p, LAS unsigned char* lds, int vcu, int G) {
    for (int u = vcu; u < 64; u += G) {
        const int n0 = u * 16;
        auto f = [&](int row, int col, const f32x4& ax, const f32x4& ay) { *(f32x4*)(OUTX(p) + (size_t)row * D + n0 + col) = ax; };
        tail_unit<false>(lds, MGX(p), D, 0, 8, WO_T(p) + (size_t)n0 * D, nullptr, D, f);
    }
}
__device__ __forceinline__ void p4_phase(const Params& p, int vcu, int G) {
    const int tid4 = fresh_tid(), lane = tid4 & 63, gw = vcu * 8 + (tid4 >> 6), NGW = G * 8;
    for (int r = gw; r < M_MAIN + NDEC; r += NGW) {
        const bool main = r < M_MAIN; const int e = r - M_MAIN;
        const f32x4* o = (const f32x4*)(main ? OUTM(p) + (size_t)r * D : OUTX(p) + (size_t)e * D);
        const f32x4* x = (const f32x4*)(main ? p.x_prompt + (size_t)r * D : p.x_sample + (size_t)e * D);
        f32x4* y = (f32x4*)(main ? p.out + O_YP + (size_t)r * D : p.out + O_YS + (size_t)e * D);
        f32x4 v[4]; float s = 0.f;
#pragma unroll
        for (int j = 0; j < 4; ++j) { v[j] = o[lane + 64 * j]; s += (v[j][0] * v[j][0] + v[j][1] * v[j][1]) + (v[j][2] * v[j][2] + v[j][3] * v[j][3]); }
        const float rs = rsqrtf(wave_sum(s) * (1.f / D) + EPS);
#pragma unroll
        for (int j = 0; j < 4; ++j) { const f32x4 w = ((const f32x4*)p.norm_post)[lane + 64 * j]; y[lane + 64 * j] = x[lane + 64 * j] + v[j] * rs * w; }
    }
}

__device__ __forceinline__ void p2_scan_simple(const Params& p, float* sm, int b, int h) {
    float* S = sm;
    float* q = S + 128 * 128;
    float* kh = q + 32 * 128;
    float* vv = kh + 32 * 128;
    float* O = vv + 32 * 128;
    float* P = O + 32 * 128;
    float* dl = P + 32 * 33;
    const int tid = threadIdx.x;
    for (int i = tid; i < 128 * 128; i += 512) S[i] = 0.f;
    __syncthreads();
    for (int j = 0; j < NMETA; ++j) {
        const size_t xo = (size_t)(NDEC + j) * D + h * HD;
        for (int i = tid; i < 128 * 128; i += 512) { const int k = i >> 7, v = i & 127; S[i] = XA(p, X_F)[xo + k] * S[i] + XA(p, X_K)[xo + k] * XA(p, X_V)[xo + v]; }
    }
    __syncthreads();
    for (int c = 0; c < SEQ / CHK; ++c) {
        const size_t row0 = (size_t)b * SEQ + c * CHK;
        for (int i = tid; i < 32 * 128; i += 512) { const int t = i >> 7, k = i & 127; const size_t g = (row0 + t) * D + h * HD + k; q[i] = bf2f(QT(p)[g]); kh[i] = bf2f(KH(p)[g]); vv[i] = bf2f(VV(p)[g]); }
        if (tid < 128) dl[tid] = DLp(p)[((size_t)b * (SEQ / CHK) + c) * D + h * HD + tid];
        __syncthreads();
        for (int i = tid; i < 1024; i += 512) { const int t = i >> 5, s = i & 31; float a = 0.f; if (s <= t) for (int k = 0; k < 128; ++k) a += q[t * 128 + k] * kh[s * 128 + k]; P[t * 33 + s] = a; }
        __syncthreads();
        for (int i = tid; i < 4096; i += 512) { const int t = i >> 7, v = i & 127; float a = 0.f; for (int k = 0; k < 128; ++k) a += q[t * 128 + k] * S[k * 128 + v]; for (int s = 0; s <= t; ++s) a += P[t * 33 + s] * vv[s * 128 + v]; O[i] = a; }
        __syncthreads();
        for (int i = tid; i < 128 * 128; i += 512) { const int k = i >> 7, v = i & 127; float a = S[i]; for (int s = 0; s < 32; ++s) a += kh[s * 128 + k] * vv[s * 128 + v]; S[i] = dl[k] * a; }
        { const int t = tid >> 4, v0 = (tid & 15) * 8; float ss = 0.f;
#pragma unroll
          for (int j = 0; j < 8; ++j) { const float x = O[t * 128 + v0 + j]; ss += x * x; }
          for (int o = 8; o > 0; o >>= 1) ss += __shfl_xor(ss, o);
          const float rs = rsqrtf(ss * (1.f / 128.f) + EPS); bf16_t* a1 = A12(p) + (row0 + t) * 2048 + h * HD + v0; f32x4 z0, z1; unpack8v(*(const uint4*)a1, z0, z1);
#pragma unroll
          for (int j = 0; j < 4; ++j) { z0[j] = O[t * 128 + v0 + j] * rs * p.hgrn_norm[v0 + j] * z0[j]; z1[j] = O[t * 128 + v0 + 4 + j] * rs * p.hgrn_norm[v0 + 4 + j] * z1[j]; }
          *(uint4*)a1 = pack8v(z0, z1); }
        __syncthreads();
    }
    float* hp = p.out + O_HP + ((size_t)b * NH + h) * 128 * 128;
    for (int i = tid; i < 128 * 128; i += 512) hp[i] = S[i];
    __syncthreads();
}
__device__ __forceinline__ void p2_decode_unit(const Params& p, float* sm, int n, int h) {
    float* red = sm;
    float* ssq = sm + 2048;
    const int tid = threadIdx.x, kq = tid >> 5, v4 = tid & 31;
    const size_t xo = (size_t)n * D + h * HD;
    const float* S = p.state_hgrn + ((size_t)n * NH + h) * 128 * 128; float* So = p.out + O_HS + ((size_t)n * NH + h) * 128 * 128;
    const f32x4 vv = *(const f32x4*)(XA(p, X_V) + xo + v4 * 4);
    f32x4 o = {0.f, 0.f, 0.f, 0.f};
    f32x4 s[8];
#pragma unroll
    for (int i = 0; i < 8; ++i) s[i] = *(const f32x4*)(S + (kq * 8 + i) * 128 + v4 * 4);
#pragma unroll
    for (int i = 0; i < 8; ++i) { const int k = kq * 8 + i; const float f = XA(p, X_F)[xo + k], kk = XA(p, X_K)[xo + k], qq = XA(p, X_Q)[xo + k];
        s[i] = f * s[i] + kk * vv; *(f32x4*)(So + k * 128 + v4 * 4) = s[i]; o += qq * s[i]; }
    __syncthreads();
    *(f32x4*)&red[kq * 128 + v4 * 4] = o;
    __syncthreads();
    float ov = 0.f;
    if (tid < 128) { for (int i = 0; i < 16; ++i) ov += red[i * 128 + tid]; float ss = ov * ov; for (int o2 = 32; o2 > 0; o2 >>= 1) ss += __shfl_xor(ss, o2); if ((tid & 63) == 0) ssq[tid >> 6] = ss; }
    __syncthreads();
    if (tid < 128) { const float rs = rsqrtf((ssq[0] + ssq[1]) * (1.f / 128.f) + EPS); A12X(p)[(size_t)n * 2048 + h * HD + tid] = f2bf(ov * rs * p.hgrn_norm[tid] * XA(p, X_SZA)[xo + tid]); }
}
__device__ __forceinline__ void p2_conv_item(const Params& p, int row, int c0) {
    f32x4 cw[3][2];
#pragma unroll
    for (int j = 0; j < 3; ++j) { cw[j][0] = *(const f32x4*)(p.conv_w + j * D + c0); cw[j][1] = *(const f32x4*)(p.conv_w + j * D + c0 + 4); }
    if (row < M_MAIN) {
        const int t = row & (SEQ - 1); f32x4 u0[2], u1[2], u2[2], w[2];
        unpack8v(*(const uint4*)(UU(p) + (size_t)row * D + c0), u2[0], u2[1]);
        if (t >= 1) unpack8v(*(const uint4*)(UU(p) + (size_t)(row - 1) * D + c0), u1[0], u1[1]); else { const float* m = XA(p, X_U) + (size_t)(NDEC + 15) * D + c0; u1[0] = *(const f32x4*)m; u1[1] = *(const f32x4*)(m + 4); }
        if (t >= 2) unpack8v(*(const uint4*)(UU(p) + (size_t)(row - 2) * D + c0), u0[0], u0[1]); else { const float* m = XA(p, X_U) + (size_t)(NDEC + 14 + t) * D + c0; u0[0] = *(const f32x4*)m; u0[1] = *(const f32x4*)(m + 4); }
        bf16_t* a2 = A12(p) + (size_t)row * 2048 + 1024 + c0; unpack8v(*(const uint4*)a2, w[0], w[1]);
#pragma unroll
        for (int n = 0; n < 2; ++n) w[n] *= cw[0][n] * u0[n] + cw[1][n] * u1[n] + cw[2][n] * u2[n];
        *(uint4*)a2 = pack8v(w[0], w[1]);
    } else {
        const int n = row - M_MAIN; const float* ctx = p.state_conv + (size_t)n * 2 * D + c0; float* cs = p.out + O_CS + (size_t)n * 2 * D + c0; f32x4 w[2];
#pragma unroll
        for (int q = 0; q < 2; ++q) { const f32x4 u = *(const f32x4*)(XA(p, X_U) + (size_t)n * D + c0 + 4 * q), c0v = *(const f32x4*)(ctx + 4 * q), c1v = *(const f32x4*)(ctx + D + 4 * q);
            w[q] = *(const f32x4*)(XA(p, X_W) + (size_t)n * D + c0 + 4 * q) * (cw[0][q] * c0v + cw[1][q] * c1v + cw[2][q] * u); *(f32x4*)(cs + 4 * q) = c1v; *(f32x4*)(cs + D + 4 * q) = u; }
        *(uint4*)(A12X(p) + (size_t)n * 2048 + 1024 + c0) = pack8v(w[0], w[1]);
    }
}
__device__ __forceinline__ void p2_phase_v1(const Params& p, unsigned char* lds, int vcu, int G) {
    float* sm = (float*)lds;
    if (vcu < 64) { p2_scan_simple(p, sm, vcu >> 3, vcu & 7); return; }
    const int w = vcu - 64, NW = G - 64;
    for (int u = w; u < NDEC * NH; u += NW) p2_decode_unit(p, sm, u >> 3, u & 7);
    const size_t nitems = (size_t)(M_MAIN + NDEC) * 128;
    for (size_t it = (size_t)w * 512 + threadIdx.x; it < nitems; it += (size_t)NW * 512) p2_conv_item(p, (int)(it >> 7), (int)(it & 127) * 8);
}

#define XB_TMO      128
#define XB_XCNT(j)  (256  + 64 * (j))
#define XB_XSUB(j)  (1280 + 64 * (j))
#define XB_XGEN(j)  (2304 + 64 * (j))
#define XB_TOP      3328
#define XB_TOPGEN   3392
#define XCD_BAR_WORDS 3456
#define XB_SPIN_CAP (1u << 18)
__device__ __forceinline__ unsigned xb_ld(unsigned* p)              { return __hip_atomic_load(p, __ATOMIC_RELAXED, __HIP_MEMORY_SCOPE_AGENT); }
__device__ __forceinline__ unsigned xb_add(unsigned* p, unsigned v) { return __hip_atomic_fetch_add(p, v, __ATOMIC_RELAXED, __HIP_MEMORY_SCOPE_AGENT); }
__device__ __forceinline__ unsigned xb_xcc_id() { return (unsigned)__builtin_amdgcn_s_getreg((3 << 11) | 20) & 0xFu; }
#define XB_SPIN(cond, bar) do { unsigned _sp = 0; while (cond) { __builtin_amdgcn_s_sleep(1); \
    if ((++_sp & 255u) == 0u) { if (xb_ld(&(bar)[XB_TMO])) break; if (_sp > XB_SPIN_CAP) { atomicAdd(&(bar)[XB_TMO], 1u); break; } } } } while (0)
struct XcdBarrier { unsigned* bar; unsigned x; volatile LAS unsigned* st; };
__device__ __forceinline__ XcdBarrier xcd_barrier_post(unsigned* bar, volatile LAS unsigned* st) {
    XcdBarrier b; b.bar = bar; b.x = xb_xcc_id(); b.st = st;
    if (threadIdx.x == 0) (void)xb_add(&bar[XB_XCNT(b.x)], 1u);
    return b;
}
__device__ __forceinline__ void xcd_barrier_complete(unsigned* bar, unsigned x, unsigned& nloc, unsigned& nx) {
    const unsigned G = gridDim.x * gridDim.y * gridDim.z;
    unsigned sum, cnt, mine, sp = 0u;
    for (;;) {
        sum = 0u; cnt = 0u; mine = 0u;
#pragma unroll
        for (unsigned j = 0; j < 16; ++j) { const unsigned c = xb_ld(&bar[XB_XCNT(j)]); sum += c; cnt += (c > 0u) ? 1u : 0u; mine = (j == x) ? c : mine; }
        if (sum == G) break;
        __builtin_amdgcn_s_sleep(1);
        if ((++sp & 255u) == 0u) { if (xb_ld(&bar[XB_TMO])) break; if (sp > XB_SPIN_CAP) { atomicAdd(&bar[XB_TMO], 1u); break; } }
    }
    nloc = mine > 0u ? mine : 1u; nx = cnt > 0u ? cnt : 1u;
}
__device__ __forceinline__ void xcd_barrier(const XcdBarrier& b) {
    asm volatile("s_waitcnt vmcnt(0)" ::: "memory");
    __syncthreads();
    if (threadIdx.x == 0) {
        unsigned* bar = b.bar;
        __builtin_amdgcn_s_waitcnt(0);
        unsigned nloc = b.st[0], nx = b.st[1];
        if (nloc == 0u) { xcd_barrier_complete(bar, b.x, nloc, nx); b.st[0] = nloc; b.st[1] = nx; }
        const unsigned old = xb_add(&bar[XB_XSUB(b.x)], 1u);
        const unsigned gen = old / nloc;
        if (old + 1u == (gen + 1u) * nloc) {
            __builtin_amdgcn_fence(__ATOMIC_RELEASE, "agent");
            asm volatile("s_waitcnt vmcnt(0)" ::: "memory");
            const unsigned og = xb_add(&bar[XB_TOP], 1u);
            const unsigned tg = og / nx;
            if (og + 1u == (tg + 1u) * nx) xb_add(&bar[XB_TOPGEN], 1u);
            else XB_SPIN(xb_ld(&bar[XB_TOPGEN]) == tg, bar);
            __builtin_amdgcn_fence(__ATOMIC_ACQUIRE, "agent");
            xb_add(&bar[XB_XGEN(b.x)], 1u);
            asm volatile("s_waitcnt vmcnt(0)" ::: "memory");
        } else {
            XB_SPIN(xb_ld(&bar[XB_XGEN(b.x)]) == gen, bar);
            __builtin_amdgcn_fence(__ATOMIC_ACQUIRE, "agent");
            asm volatile("s_waitcnt vmcnt(0)" ::: "memory");
        }
    }
    __syncthreads();
}

constexpr int LDS_BYTES = 147456;
constexpr int MISC_OFF = LDS_BYTES - 256;
constexpr int CW_BAR = 4096;
constexpr size_t CTL_ZERO_BYTES = 65536;
#ifndef MK_N_LAUNCHES
#define MK_N_LAUNCHES 1
#endif
constexpr int NPHASE = 6;
struct Args { Params p; int ph_lo, ph_hi; };
__global__ void __launch_bounds__(512, 2) mega_fwd(Args a) {
    extern __shared__ __attribute__((aligned(16))) unsigned char lds_raw[];
    LAS unsigned char* lds = (LAS unsigned char*)lds_raw;
    const Params& p = a.p;
    const int tid = threadIdx.x, G = gridDim.x, bx = blockIdx.x;
    const int vcu = (G % 8 == 0) ? (bx % 8) * (G / 8) + bx / 8 : bx;
    volatile LAS unsigned* MISC = (volatile LAS unsigned*)(lds + MISC_OFF);
    if (tid < 64) MISC[tid] = 0u;
    __syncthreads();
    XcdBarrier bar; bar.bar = (unsigned*)(p.ws + WS_CTL) + CW_BAR; bar.x = 0; bar.st = nullptr;
    if (MK_N_LAUNCHES == 1) bar = xcd_barrier_post((unsigned*)(p.ws + WS_CTL) + CW_BAR, MISC + 8);
    const int lo = a.ph_lo, hi = a.ph_hi;
#define IN(k) (lo <= (k) && (k) < hi)
#define SEAM(k) do { if (IN(k) && IN((k) + 1)) xcd_barrier(bar); } while (0)
    if (IN(0)) { p0_phase(p, lds, vcu, G); }
    SEAM(0);
    if (IN(1)) {
        pg8::Gemm g{XN(p), WIN_T(p), M_MAIN, DIN, D}; pg8::StaticOrder S; S.init(M_MAIN, DIN, G, bx);
        EpiP1 E{p};
        pg8::gemm_phase<EpiP1, pg8::StaticOrder, true, true, false>(lds, g, S, E);
        p1_extras(p, lds, vcu, G);
    }
    SEAM(1);
    if (IN(2)) { p2_phase_v1(p, lds_raw, vcu, G); }
    SEAM(2);
    if (IN(3)) {
        pg8::Gemm g{A12(p), WAB_T(p), M_MAIN, D, 2048}; pg8::StaticOrder S; S.init(M_MAIN, D, G, bx);
        EpiMG E{p};
        pg8::gemm_phase<EpiMG, pg8::StaticOrder, false, true, true>(lds, g, S, E);
        p3a_extras(p, lds, vcu, G);
    }
    SEAM(3);
    if (IN(4)) {
        pg8::Gemm g{MG(p), WO_T(p), M_MAIN, D, D}; pg8::StaticOrder S; S.init(M_MAIN, D, G, bx);
        EpiOut E{OUTM(p)};
        pg8::gemm_phase<EpiOut, pg8::StaticOrder, false, true, false>(lds, g, S, E);
        p3b_extras(p, lds, vcu, G);
    }
    SEAM(4);
    if (IN(5)) { p4_phase(p, vcu, G); }
#undef IN
#undef SEAM
}

extern "C" void kernel_launch(void* const* d_in, const int* in_sizes, int n_in, void* d_out, int out_size, void* d_ws, size_t ws_size, hipStream_t stream) {
    static int grid = 0;
    if (grid == 0) {
        int dev = 0, cus = 0;
        if (hipGetDevice(&dev) != hipSuccess || hipDeviceGetAttribute(&cus, hipDeviceAttributeMultiprocessorCount, dev) != hipSuccess) { fprintf(stderr, "kernel_launch: device query failed\n"); grid = -1; return; }
        if (hipFuncSetAttribute((const void*)mega_fwd, hipFuncAttributeMaxDynamicSharedMemorySize, LDS_BYTES) != hipSuccess) { fprintf(stderr, "kernel_launch: hipFuncSetAttribute failed\n"); grid = -1; return; }
        int per_cu = 0;
        if (hipOccupancyMaxActiveBlocksPerMultiprocessor(&per_cu, (const void*)mega_fwd, 512, LDS_BYTES) != hipSuccess || per_cu < 1) fprintf(stderr, "kernel_launch: occupancy query reports %d blocks/CU\n", per_cu);
        (void)hipGetLastError();
        grid = cus;
        if (grid != 256) fprintf(stderr, "kernel_launch: %d CUs (built for 256)\n", grid);
    }
    if (grid < 0) return;
    (void)hipMemsetAsync((char*)d_ws + WS_CTL, 0, CTL_ZERO_BYTES, stream);
    Args a{};
    a.p.x_prompt = (const float*)d_in[0]; a.p.x_sample = (const float*)d_in[1]; a.p.state_hgrn = (const float*)d_in[2]; a.p.state_conv = (const float*)d_in[3]; a.p.meta = (const float*)d_in[4];
    a.p.w_in = (const float*)d_in[5]; a.p.norm_pre = (const float*)d_in[6]; a.p.norm_post = (const float*)d_in[7]; a.p.lb_logits = (const float*)d_in[8]; a.p.hgrn_norm = (const float*)d_in[9];
    a.p.conv_w = (const float*)d_in[10]; a.p.w_a = (const float*)d_in[11]; a.p.w_b = (const float*)d_in[12]; a.p.w_o = (const float*)d_in[13];
    a.p.out = (float*)d_out; a.p.ws = (unsigned char*)d_ws;
    if (MK_N_LAUNCHES == 1) { a.ph_lo = 0; a.ph_hi = NPHASE; hipLaunchKernelGGL(mega_fwd, dim3(grid), dim3(512), LDS_BYTES, stream, a); }
    else for (int k = 0; k < NPHASE; ++k) { a.ph_lo = k; a.ph_hi = k + 1; hipLaunchKernelGGL(mega_fwd, dim3(grid), dim3(512), LDS_BYTES, stream, a); }
}
```

```cpp
#include <hip/hip_runtime.h>
#include <cstdint>
#include <cstdio>

typedef unsigned short bf16_t;
__device__ __forceinline__ int fresh_tid() { int t = threadIdx.x; asm volatile("" : "+v"(t)); return t; }

constexpr int D = 1024, NB = 8, SEQ = 2048, NDEC = 128, NMETA = 16, NH = 8, HD = 128, DIN = 10240;
constexpr int M_MAIN = NB * SEQ;
constexpr int NX = NDEC + NMETA;
constexpr int NXA = 160;
constexpr int NXP = 256;
constexpr int CHK = 32, NCHUNK = M_MAIN / CHK;
constexpr float EPS = 1e-6f;

constexpr size_t O_YP = 0, O_YS = 16777216, O_HP = O_YS + 131072, O_HS = O_HP + 1048576, O_CP = O_HS + 16777216, O_CS = O_CP + 16384;

constexpr size_t MiB = 1u << 20;
constexpr size_t WS_CTL = 0, WS_WIN = 1 * MiB, WS_WAB = 21 * MiB, WS_WO = 25 * MiB, WS_DL = 27 * MiB, WS_X = 30 * MiB;
constexpr size_t XSTRIDE = (size_t)NXA * D * 4;
constexpr size_t WS_A12X = 36 * MiB, WS_MGX = 37 * MiB;
constexpr size_t WS_QT = 38 * MiB, WS_KH = 70 * MiB, WS_V = 102 * MiB, WS_A12 = 134 * MiB, WS_U = 198 * MiB, WS_MG = WS_QT;
enum { X_Q = 0, X_K, X_F, X_V, X_SZA, X_W, X_U, X_RT, X_GB, X_N };

struct Params {
    const float *x_prompt, *x_sample, *state_hgrn, *state_conv, *meta, *w_in, *norm_pre, *norm_post, *lb_logits, *hgrn_norm, *conv_w, *w_a, *w_b, *w_o;
    float* out;
    unsigned char* ws;
};
__device__ __forceinline__ bf16_t* WIN_T(const Params& p) { return (bf16_t*)(p.ws + WS_WIN); }
__device__ __forceinline__ bf16_t* WAB_T(const Params& p) { return (bf16_t*)(p.ws + WS_WAB); }
__device__ __forceinline__ bf16_t* WO_T(const Params& p) { return (bf16_t*)(p.ws + WS_WO); }
__device__ __forceinline__ float* DLp(const Params& p) { return (float*)(p.ws + WS_DL); }
__device__ __forceinline__ float* XA(const Params& p, int i) { return (float*)(p.ws + WS_X + (size_t)i * XSTRIDE); }
__device__ __forceinline__ bf16_t* A12X(const Params& p) { return (bf16_t*)(p.ws + WS_A12X); }
__device__ __forceinline__ bf16_t* MGX(const Params& p) { return (bf16_t*)(p.ws + WS_MGX); }
__device__ __forceinline__ bf16_t* QT(const Params& p) { return (bf16_t*)(p.ws + WS_QT); }
__device__ __forceinline__ bf16_t* KH(const Params& p) { return (bf16_t*)(p.ws + WS_KH); }
__device__ __forceinline__ bf16_t* VV(const Params& p) { return (bf16_t*)(p.ws + WS_V); }
__device__ __forceinline__ bf16_t* A12(const Params& p) { return (bf16_t*)(p.ws + WS_A12); }
__device__ __forceinline__ bf16_t* UU(const Params& p) { return (bf16_t*)(p.ws + WS_U); }
__device__ __forceinline__ bf16_t* MG(const Params& p) { return (bf16_t*)(p.ws + WS_MG); }
__device__ __forceinline__ bf16_t* XN(const Params& p) { return (bf16_t*)(p.out + O_HS); }
__device__ __forceinline__ bf16_t* RT(const Params& p) { return (bf16_t*)(p.out + O_YP); }
__device__ __forceinline__ bf16_t* GB(const Params& p) { return (bf16_t*)(p.out + O_YP) + (size_t)M_MAIN * D; }

__device__ __forceinline__ float bf2f(bf16_t h) { return __uint_as_float(((unsigned)h) << 16); }
__device__ __forceinline__ bf16_t f2bf(float f) { unsigned u = __float_as_uint(f); return (bf16_t)((u + 0x7fffu + ((u >> 16) & 1u)) >> 16); }
__device__ __forceinline__ float clampf(float x, float lo, float hi) { return fminf(fmaxf(x, lo), hi); }
__device__ __forceinline__ float sigm(float x) { return 1.f / (1.f + __expf(-clampf(x, -30.f, 30.f))); }
__device__ __forceinline__ float silu(float x) { return x * sigm(x); }
__device__ __forceinline__ void unpack8(uint4 v, float* f) {
    f[0] = __uint_as_float(v.x << 16); f[1] = __uint_as_float(v.x & 0xffff0000u); f[2] = __uint_as_float(v.y << 16); f[3] = __uint_as_float(v.y & 0xffff0000u);
    f[4] = __uint_as_float(v.z << 16); f[5] = __uint_as_float(v.z & 0xffff0000u); f[6] = __uint_as_float(v.w << 16); f[7] = __uint_as_float(v.w & 0xffff0000u);
}
__device__ __forceinline__ uint4 pack8(const float* f) {
    uint4 v; v.x = f2bf(f[0]) | ((unsigned)f2bf(f[1]) << 16); v.y = f2bf(f[2]) | ((unsigned)f2bf(f[3]) << 16);
    v.z = f2bf(f[4]) | ((unsigned)f2bf(f[5]) << 16); v.w = f2bf(f[6]) | ((unsigned)f2bf(f[7]) << 16); return v;
}
__host__ __device__ __forceinline__ int srccol(int n) {
    const int pn = n >> 8, bj = (n >> 7) & 1, j = n & 127, T = pn >> 3, cb = pn & 7;
    const int split = ((bj ? 0x96731 : 0x85420) >> (4 * T)) & 15;
    return split * 1024 + cb * 128 + j;
}
__device__ __forceinline__ int nrow_x(int T, int c) { return 256 * (T * 8 + (c >> 7)) + (c & 127); }
__device__ __forceinline__ float lbound(const Params& p, int c) { return 1.f / (1.f + __expf(p.lb_logits[1024 + c] - p.lb_logits[c])); }


namespace pg8 {
#define PG8_LAS __attribute__((address_space(3)))
typedef unsigned short bf16_t;
typedef short bf16x8 __attribute__((ext_vector_type(8)));
typedef float f32x4 __attribute__((ext_vector_type(4)));
typedef unsigned u32x4 __attribute__((ext_vector_type(4)));
constexpr int BM = 256, BK = 64, HALF = 128, HTB = HALF * BK * 2  , STAGE_BYTES = 8 * HTB, NXCD = 8, WGM = 8;

__host__ __device__ __forceinline__ int lds_byte(int r, int c) { const int st = (r >> 4) * 2 + (c >> 5), rr = r & 15, cc = c & 31, ob = rr * 64 + cc * 2; return st * 1024 + (ob ^ (((ob >> 9) & 1) << 5)); }
__host__ __device__ __forceinline__ void stage_rc(int b, int& R, int& C) { const int st = b / 1024, sb = b % 1024, swz = sb ^ (((sb >> 9) & 1) << 5); R = (st >> 1) * 16 + swz / 64; C = (st & 1) * 32 + (swz % 64) / 2; }
__host__ __device__ __forceinline__ int perm32(int rho) { const int n = rho >> 4, i = rho & 15; return 8 * (i >> 2) + 4 * n + (i & 3); }

struct Unit { int pm, pn; };
struct Gemm { const bf16_t* A; const bf16_t* Bt; int M, N, K; };

struct StaticOrder {
    int nM, nN, nwg, G, c;
    __host__ __device__ void init(int M, int N, int G_, int c_) { nM = M / BM; nN = N / BM; nwg = nM * nN; G = G_; c = c_; }
    __host__ __device__ bool next(int i, Unit& u) const {
        const long L = (long)i * G + c; if (L >= nwg) return false;
        int wgid = (int)L; { const int q = nwg / NXCD, r = nwg % NXCD, xcd = wgid % NXCD, off = wgid / NXCD; wgid = (xcd < r ? xcd * (q + 1) : r * (q + 1) + (xcd - r) * q) + off; }
        const int nig = WGM * nN, gid = wgid / nig, fm = gid * WGM, gsz = (nM - fm) < WGM ? (nM - fm) : WGM;
        u.pm = fm + ((wgid % nig) % gsz); u.pn = (wgid % nig) / gsz; return true;
    }
    __device__ __forceinline__ void a_ready(const Unit&) const {}
    __device__ __forceinline__ void done(const Unit&) const {}
};


template <class Epi, class Sched, bool ALIGN_EPI = false, bool SP2 = false, bool MIDK = false>
__device__ __forceinline__ void gemm_phase(PG8_LAS unsigned char* lds, const Gemm g, const Sched& S, const Epi& E) {
    const int tid = fresh_tid(), wid = __builtin_amdgcn_readfirstlane(tid >> 6), lane = tid & 63, wr = wid >> 2, wc = wid & 3, fr = lane & 15, fq = lane >> 4;
    const int K = g.K, nt = K / BK;
    unsigned voffA[2], voffB[2];
#pragma unroll
    for (int i = 0; i < 2; ++i) { int R, C; stage_rc(tid * 16 + i * 8192, R, C); const int Rb = Epi::PERM ? ((R & ~31) + perm32(R & 31)) : R;
        voffA[i] = (unsigned)(R * K + C) * 2u; voffB[i] = (unsigned)(Rb * K + C) * 2u; }
    const size_t kstep = (size_t)(BK * 2);
    const size_t hstep = (size_t)HALF * K * 2;
    const size_t tstep = 2 * hstep;
    const unsigned ldsw = (unsigned)wid * 1024u;
    const int aoff = lds_byte(wr * 64 + fr, fq * 8), boff = lds_byte(wc * 32 + fr, fq * 8);
#define PG8_SA(b, h) (((b) * 2 + (h)) * HTB)
#define PG8_SB(b, h) ((4 + (b) * 2 + (h)) * HTB)
#define PG8_STAGE(bufoff, gbase, voff) do { _Pragma("unroll") for (int _i = 0; _i < 2; ++_i) \
        __builtin_amdgcn_global_load_lds((const unsigned*)((const char*)(gbase) + (voff)[_i]), (PG8_LAS unsigned*)(lds + (bufoff) + ldsw + _i * 8192), 16, 0, 0); } while (0)
#define PG8_LDA(dst, b, h) do { _Pragma("unroll") for (int m = 0; m < 4; ++m) _Pragma("unroll") for (int k = 0; k < 2; ++k) dst[m][k] = *(const PG8_LAS bf16x8*)(lds + PG8_SA(b, h) + aoff + m * 2048 + k * 1024); } while (0)
#define PG8_LDB(dst, b, h) do { _Pragma("unroll") for (int n = 0; n < 2; ++n) _Pragma("unroll") for (int k = 0; k < 2; ++k) dst[n][k] = *(const PG8_LAS bf16x8*)(lds + PG8_SB(b, h) + boff + n * 2048 + k * 1024); } while (0)
#define PG8_MMA(ai, bj, At, Bt) do { __builtin_amdgcn_s_setprio(1); _Pragma("unroll") for (int m = 0; m < 4; ++m) _Pragma("unroll") for (int n = 0; n < 2; ++n) _Pragma("unroll") for (int k = 0; k < 2; ++k) \
        acc[ai][bj][m][n] = __builtin_amdgcn_mfma_f32_16x16x32_bf16(Bt[n][k], At[m][k], acc[ai][bj][m][n], 0, 0, 0); __builtin_amdgcn_s_setprio(0); } while (0)
#define PG8_WAIT_V(n) asm volatile("s_waitcnt vmcnt(" #n ")" ::: "memory")
#define PG8_WAIT_L(n) asm volatile("s_waitcnt lgkmcnt(" #n ")" ::: "memory")
#define PG8_BAR __builtin_amdgcn_s_barrier()
#define PG8_SCHED __builtin_amdgcn_sched_barrier(0)
    Unit cur, nxt; int ui = 0;
    if (!S.next(0, cur)) return;
    f32x4 acc[2][2][4][2];
#pragma unroll
    for (int a = 0; a < 2; ++a)
#pragma unroll
        for (int b = 0; b < 2; ++b)
#pragma unroll
            for (int m = 0; m < 4; ++m)
#pragma unroll
                for (int n = 0; n < 2; ++n) acc[a][b][m][n] = (f32x4){0.f, 0.f, 0.f, 0.f};
    bf16x8 At[4][2], B0[2][2], B1[2][2];
    const char* cA = (const char*)g.A + (size_t)cur.pm * tstep; const char* cB = (const char*)g.Bt + (size_t)cur.pn * tstep;
    S.a_ready(cur);
    if constexpr (SP2) {
        PG8_STAGE(PG8_SB(0, 0), cB, voffB); PG8_STAGE(PG8_SB(0, 1), cB + hstep, voffB); PG8_STAGE(PG8_SA(0, 0), cA, voffA); PG8_STAGE(PG8_SA(0, 1), cA + hstep, voffA);
        if (wr == 1) PG8_BAR;
        PG8_WAIT_V(2); PG8_BAR;
        PG8_STAGE(PG8_SB(1, 0), cB + kstep, voffB); PG8_STAGE(PG8_SA(1, 0), cA + kstep, voffA); PG8_STAGE(PG8_SB(1, 1), cB + hstep + kstep, voffB);
        PG8_WAIT_V(6); PG8_BAR;
    } else {
        PG8_STAGE(PG8_SB(0, 0), cB, voffB); PG8_STAGE(PG8_SA(0, 0), cA, voffA); PG8_STAGE(PG8_SB(0, 1), cB + hstep, voffB); PG8_STAGE(PG8_SA(0, 1), cA + hstep, voffA);
        if (wr == 1) PG8_BAR;
        PG8_WAIT_V(4); PG8_BAR;
        PG8_STAGE(PG8_SB(1, 0), cB + kstep, voffB); PG8_STAGE(PG8_SA(1, 0), cA + kstep, voffA); PG8_STAGE(PG8_SB(1, 1), cB + hstep + kstep, voffB);
        PG8_WAIT_V(6); PG8_BAR;
    }
    for (;;) {
        const bool has_next = S.next(ui + 1, nxt);
        const char* nA = has_next ? (const char*)g.A + (size_t)nxt.pm * tstep : cA; const char* nB = has_next ? (const char*)g.Bt + (size_t)nxt.pn * tstep : cB;
        for (int t = 0; t < nt; t += 2) {
            const bool last = (t == nt - 2);
            const char* a1 = cA + (size_t)(t + 1) * kstep;
            const char* a2 = last ? nA : cA + (size_t)(t + 2) * kstep; const char* b2 = last ? nB : cB + (size_t)(t + 2) * kstep;
            const char* a3 = a2 + kstep; const char* b3 = b2 + kstep;
            if (last && has_next) S.a_ready(nxt);
            if constexpr (MIDK) { if (t == nt / 2) E.mid(acc, cur, wr, wc, fr, fq); }
            if constexpr (SP2) {
            PG8_LDB(B0, 0, 0); PG8_LDB(B1, 0, 1); PG8_SCHED; PG8_LDA(At, 0, 0); PG8_STAGE(PG8_SA(1, 1), a1 + hstep, voffA);
            PG8_WAIT_V(8); PG8_WAIT_L(0); PG8_BAR; PG8_MMA(0, 0, At, B0); PG8_MMA(0, 1, At, B1); PG8_BAR; PG8_SCHED;
            PG8_LDA(At, 0, 1); PG8_STAGE(PG8_SB(0, 0), b2, voffB); PG8_STAGE(PG8_SB(0, 1), b2 + hstep, voffB); PG8_STAGE(PG8_SA(0, 0), a2, voffA);
            PG8_WAIT_V(8); PG8_WAIT_L(0); PG8_BAR; PG8_MMA(1, 0, At, B0); PG8_MMA(1, 1, At, B1); PG8_BAR; PG8_SCHED;
            PG8_LDB(B0, 1, 0); PG8_LDB(B1, 1, 1); PG8_SCHED; PG8_LDA(At, 1, 0); PG8_STAGE(PG8_SA(0, 1), a2 + hstep, voffA);
            PG8_WAIT_V(8); PG8_WAIT_L(0); PG8_BAR; PG8_MMA(0, 0, At, B0); PG8_MMA(0, 1, At, B1); PG8_BAR; PG8_SCHED;
            PG8_LDA(At, 1, 1); PG8_STAGE(PG8_SB(1, 0), b3, voffB); PG8_STAGE(PG8_SB(1, 1), b3 + hstep, voffB); PG8_STAGE(PG8_SA(1, 0), a3, voffA);
            PG8_WAIT_V(8); PG8_WAIT_L(0); PG8_BAR; PG8_MMA(1, 0, At, B0); PG8_MMA(1, 1, At, B1); PG8_BAR; PG8_SCHED;
            } else {
            PG8_LDB(B0, 0, 0); PG8_SCHED; PG8_LDA(At, 0, 0); PG8_STAGE(PG8_SA(1, 1), a1 + hstep, voffA);
            PG8_WAIT_L(8); PG8_BAR; PG8_WAIT_L(0); PG8_MMA(0, 0, At, B0); PG8_BAR; PG8_SCHED;
            PG8_LDB(B1, 0, 1); PG8_STAGE(PG8_SB(0, 0), b2, voffB);
            PG8_BAR; PG8_WAIT_L(0); PG8_MMA(0, 1, At, B1); PG8_BAR;
            PG8_LDA(At, 0, 1); PG8_STAGE(PG8_SA(0, 0), a2, voffA);
            PG8_BAR; PG8_WAIT_L(0); PG8_MMA(1, 0, At, B0); PG8_BAR; PG8_SCHED;
            PG8_STAGE(PG8_SB(0, 1), b2 + hstep, voffB);
            PG8_WAIT_V(6); PG8_BAR; PG8_MMA(1, 1, At, B1); PG8_BAR;
            PG8_LDB(B0, 1, 0); PG8_SCHED; PG8_LDA(At, 1, 0); PG8_STAGE(PG8_SA(0, 1), a2 + hstep, voffA);
            PG8_WAIT_L(8); PG8_BAR; PG8_WAIT_L(0); PG8_MMA(0, 0, At, B0); PG8_BAR; PG8_SCHED;
            PG8_LDB(B1, 1, 1); PG8_STAGE(PG8_SB(1, 0), b3, voffB);
            PG8_BAR; PG8_WAIT_L(0); PG8_MMA(0, 1, At, B1); PG8_BAR;
            PG8_LDA(At, 1, 1); PG8_STAGE(PG8_SA(1, 0), a3, voffA);
            PG8_BAR; PG8_WAIT_L(0); PG8_MMA(1, 0, At, B0); PG8_BAR; PG8_SCHED;
            PG8_STAGE(PG8_SB(1, 1), b3 + hstep, voffB);
            PG8_WAIT_V(6); PG8_BAR; PG8_MMA(1, 1, At, B1); PG8_BAR;
            }
        }
        if constexpr (ALIGN_EPI) { if (wr == 0) PG8_BAR; }
        if constexpr (!Epi::AFTER_DRAIN) { E(acc, cur, wr, wc, fr, fq); S.done(cur); }
        if (!has_next) break;
#pragma unroll
        for (int a = 0; a < 2; ++a)
#pragma unroll
            for (int b = 0; b < 2; ++b)
#pragma unroll
                for (int m = 0; m < 4; ++m)
#pragma unroll
                    for (int n = 0; n < 2; ++n) acc[a][b][m][n] = (f32x4){0.f, 0.f, 0.f, 0.f};
        cur = nxt; cA = nA; cB = nB; ++ui;
        if constexpr (ALIGN_EPI) { if (wr == 1) PG8_BAR; }
    }
    PG8_WAIT_V(0);
    if constexpr (!ALIGN_EPI) { if (wr == 0) PG8_BAR; }
    PG8_BAR;
    if constexpr (Epi::AFTER_DRAIN) { E.fused(acc, cur, wr, wc, fr, fq, lds, wid, lane); S.done(cur); }
#undef PG8_SA
#undef PG8_SB
#undef PG8_STAGE
#undef PG8_LDA
#undef PG8_LDB
#undef PG8_MMA
#undef PG8_WAIT_V
#undef PG8_WAIT_L
#undef PG8_BAR
#undef PG8_SCHED
}
}

#define LAS __attribute__((address_space(3)))
typedef float f32x4 __attribute__((ext_vector_type(4)));
typedef float f32x2_t __attribute__((ext_vector_type(2)));
typedef __bf16 bf16x2_t __attribute__((ext_vector_type(2)));
typedef short bf16x8 __attribute__((ext_vector_type(8)));
__device__ __forceinline__ unsigned cvtpk(float lo, float hi) { f32x2_t v = {lo, hi}; bf16x2_t b = __builtin_convertvector(v, bf16x2_t); return __builtin_bit_cast(unsigned, b); }
__device__ __forceinline__ uint4 pack8v(f32x4 a, f32x4 b) { uint4 v; v.x = cvtpk(a[0], a[1]); v.y = cvtpk(a[2], a[3]); v.z = cvtpk(b[0], b[1]); v.w = cvtpk(b[2], b[3]); return v; }
__device__ __forceinline__ void unpack8v(uint4 v, f32x4& a, f32x4& b) {
    a[0] = __uint_as_float(v.x << 16); a[1] = __uint_as_float(v.x & 0xffff0000u); a[2] = __uint_as_float(v.y << 16); a[3] = __uint_as_float(v.y & 0xffff0000u);
    b[0] = __uint_as_float(v.z << 16); b[1] = __uint_as_float(v.z & 0xffff0000u); b[2] = __uint_as_float(v.w << 16); b[3] = __uint_as_float(v.w & 0xffff0000u);
}
__device__ __forceinline__ float fexp(float x) { return __expf(x); }
__device__ __forceinline__ float frcp(float x) { return __builtin_amdgcn_rcpf(x); }
template <int CTRL> __device__ __forceinline__ float dppf(float v) { return __int_as_float(__builtin_amdgcn_update_dpp(0, __float_as_int(v), CTRL, 0xf, 0xf, false)); }
__device__ __forceinline__ float scan16(float x) {
    x += dppf<0x111>(x); x += dppf<0x112>(x); x += dppf<0x114>(x); x += dppf<0x118>(x); return x;
}
__device__ __forceinline__ float wave_sum(float v) {
#pragma unroll
    for (int o = 1; o < 64; o <<= 1) v += __shfl_xor(v, o);
    return v;
}

struct EpiP1 {
    static constexpr bool PERM = true, AFTER_DRAIN = false;
    Params p;
    __device__ __forceinline__ void operator()(const f32x4 (&acc)[2][2][4][2], const pg8::Unit& u, int wr, int wc, int fr, int fq) const {
        const int T = u.pn >> 3;
        const int c0 = (u.pn & 7) * 128 + wc * 32 + fq * 8;
        const int rbase = u.pm * 256 + wr * 64 + fr;
        if (T == 0) {
#pragma unroll
            for (int ai = 0; ai < 2; ++ai)
#pragma unroll
                for (int mp = 0; mp < 2; ++mp) {
                    uint2 qtp[2][2], khp[2][2];
                    f32x4 dlv[2];
#pragma unroll
                    for (int n = 0; n < 2; ++n) {
                        f32x4 lb, om, qa[2], kk[2], G[2];
#pragma unroll
                        for (int e = 0; e < 4; ++e) { lb[e] = lbound(p, c0 + 4 * n + e); om[e] = 1.f - lb[e]; }
#pragma unroll
                        for (int hf = 0; hf < 2; ++hf)
#pragma unroll
                            for (int e = 0; e < 4; ++e) {
                                const float x = acc[ai][0][2 * mp + hf][n][e], y = acc[ai][1][2 * mp + hf][n][e];
                                const float ee = fexp(-clampf(y, -30.f, 30.f)), sg = frcp(1.f + ee);
                                qa[hf][e] = x * frcp(1.f + fexp(-clampf(x, -30.f, 30.f)));
                                kk[hf][e] = om[e] * ee * sg;
                                G[hf][e] = __logf(lb[e] + om[e] * sg);
                            }
#pragma unroll
                        for (int e = 0; e < 4; ++e) {
                            const float s0 = scan16(G[0][e]);
                            const float t0 = __shfl(s0, (int)((threadIdx.x & 48) | 15));
                            G[0][e] = s0; G[1][e] = scan16(G[1][e]) + t0;
                        }
#pragma unroll
                        for (int hf = 0; hf < 2; ++hf) {
                            f32x4 qt, kh;
#pragma unroll
                            for (int e = 0; e < 4; ++e) { const float eg = fexp(fmaxf(G[hf][e], -80.f)); qt[e] = qa[hf][e] * eg; kh[e] = kk[hf][e] * frcp(eg); }
                            qtp[hf][n] = make_uint2(cvtpk(qt[0], qt[1]), cvtpk(qt[2], qt[3])); khp[hf][n] = make_uint2(cvtpk(kh[0], kh[1]), cvtpk(kh[2], kh[3]));
                        }
#pragma unroll
                        for (int e = 0; e < 4; ++e) dlv[n][e] = fexp(G[1][e]);
                    }
#pragma unroll
                    for (int hf = 0; hf < 2; ++hf) {
                        const size_t o = (size_t)(rbase + 128 * ai + 32 * mp + 16 * hf) * D + c0;
                        *(uint4*)(QT(p) + o) = make_uint4(qtp[hf][0].x, qtp[hf][0].y, qtp[hf][1].x, qtp[hf][1].y);
                        *(uint4*)(KH(p) + o) = make_uint4(khp[hf][0].x, khp[hf][0].y, khp[hf][1].x, khp[hf][1].y);
                    }
                    if (fr == 15) {
                        const int chunk = (u.pm * 256 + 128 * ai + 64 * wr + 32 * mp) >> 5;
                        float* dp = DLp(p) + (size_t)chunk * D + c0; *(f32x4*)dp = dlv[0]; *(f32x4*)(dp + 4) = dlv[1];
                    }
                }
            return;
        }
#pragma unroll
        for (int ai = 0; ai < 2; ++ai)
#pragma unroll
            for (int m = 0; m < 4; ++m) {
                const int row = rbase + 128 * ai + 16 * m;
                const f32x4 x0 = acc[ai][0][m][0], x1 = acc[ai][0][m][1], y0 = acc[ai][1][m][0], y1 = acc[ai][1][m][1];
                f32x4 r0, r1, s0, s1;
                if (T == 1) {
#pragma unroll
                    for (int e = 0; e < 4; ++e) { s0[e] = y0[e] * frcp(1.f + fexp(-clampf(y0[e], -30.f, 30.f))); s1[e] = y1[e] * frcp(1.f + fexp(-clampf(y1[e], -30.f, 30.f))); }
                    *(uint4*)(VV(p) + (size_t)row * D + c0) = pack8v(x0, x1);
                    *(uint4*)(A12(p) + (size_t)row * 2048 + c0) = pack8v(s0, s1);
                } else if (T == 2) {
#pragma unroll
                    for (int e = 0; e < 4; ++e) { r0[e] = x0[e] * y0[e] * frcp(1.f + fexp(-clampf(y0[e], -30.f, 30.f))); r1[e] = x1[e] * y1[e] * frcp(1.f + fexp(-clampf(y1[e], -30.f, 30.f))); }
                    *(uint4*)(A12(p) + (size_t)row * 2048 + 1024 + c0) = pack8v(r0, r1);
                } else if (T == 3) {
                    r0 = x0 * y0; r1 = x1 * y1;
                    *(uint4*)(UU(p) + (size_t)row * D + c0) = pack8v(r0, r1);
                    const int t = row & (SEQ - 1);
                    if (t >= SEQ - 2) { float* cp = p.out + O_CP + ((size_t)(row >> 11) * 2 + (t - (SEQ - 2))) * D + c0; *(f32x4*)cp = r0; *(f32x4*)(cp + 4) = r1; }
                } else {
#pragma unroll
                    for (int e = 0; e < 4; ++e) {
                        const float ea0 = fexp(-clampf(x0[e], -30.f, 30.f)), eb0 = fexp(-clampf(y0[e], -30.f, 30.f)), ea1 = fexp(-clampf(x1[e], -30.f, 30.f)), eb1 = fexp(-clampf(y1[e], -30.f, 30.f));
                        r0[e] = (1.f + eb0) * frcp(1.f + ea0); r1[e] = (1.f + eb1) * frcp(1.f + ea1); s0[e] = frcp(1.f + eb0); s1[e] = frcp(1.f + eb1);
                    }
                    *(uint4*)(RT(p) + (size_t)row * D + c0) = pack8v(r0, r1);
                    *(uint4*)(GB(p) + (size_t)row * D + c0) = pack8v(s0, s1);
                }
            }
    }
};
struct EpiMG {
    static constexpr bool PERM = true, AFTER_DRAIN = false;
    Params p;
    __device__ __forceinline__ void mid(f32x4 (&acc)[2][2][4][2], const pg8::Unit& u, int wr, int wc, int fr, int fq) const {
        int rbase = u.pm * 256 + wr * 64 + fr, cb = u.pn * 256 + wc * 32 + fq * 8; asm volatile("" : "+v"(rbase), "+v"(cb));
#pragma unroll
        for (int ai = 0; ai < 2; ++ai)
#pragma unroll
            for (int m = 0; m < 4; ++m)
#pragma unroll
                for (int bj = 0; bj < 2; ++bj) { f32x4 a, b; unpack8v(*(const uint4*)(RT(p) + (size_t)(rbase + 128 * ai + 16 * m) * D + cb + 128 * bj), a, b); acc[ai][bj][m][0] *= a; acc[ai][bj][m][1] *= b; }
    }
    __device__ __forceinline__ void operator()(const f32x4 (&acc)[2][2][4][2], const pg8::Unit& u, int wr, int wc, int fr, int fq) const {
        int rbase = u.pm * 256 + wr * 64 + fr, cb = u.pn * 256 + wc * 32 + fq * 8; asm volatile("" : "+v"(rbase), "+v"(cb));
#pragma unroll
        for (int ai = 0; ai < 2; ++ai)
#pragma unroll
            for (int m = 0; m < 4; ++m)
#pragma unroll
                for (int bj = 0; bj < 2; ++bj) { const size_t o = (size_t)(rbase + 128 * ai + 16 * m) * D + cb + 128 * bj; f32x4 a, b; unpack8v(*(const uint4*)(GB(p) + o), a, b);
                    *(uint4*)(MG(p) + o) = pack8v(acc[ai][bj][m][0] * a, acc[ai][bj][m][1] * b); }
    }
};
struct EpiOut {
    static constexpr bool PERM = false, AFTER_DRAIN = false;
    float* C;
    __device__ __forceinline__ void operator()(const f32x4 (&acc)[2][2][4][2], const pg8::Unit& u, int wr, int wc, int fr, int fq) const {
        const int row0 = u.pm * 256 + wr * 64 + fr, col0 = u.pn * 256 + wc * 32 + 4 * fq;
#pragma unroll
        for (int ai = 0; ai < 2; ++ai)
#pragma unroll
            for (int m = 0; m < 4; ++m) { float* rowp = C + (size_t)(row0 + ai * 128 + m * 16) * D + col0;
#pragma unroll
                for (int bj = 0; bj < 2; ++bj)
#pragma unroll
                    for (int n = 0; n < 2; ++n) *(f32x4*)(rowp + bj * 128 + n * 16) = acc[ai][bj][m][n]; }
    }
};

constexpr int TG_BROW = 2048 + 16;
template <bool DUAL, class F>
__device__ __forceinline__ void tail_unit(LAS unsigned char* lds, const bf16_t* A, int lda, int aoff_y, int nrb, const bf16_t* Bx, const bf16_t* By, int ldb, const F& f) {
    const int tid = fresh_tid(), lane = tid & 63, wid = tid >> 6, fr = lane & 15, fq = lane >> 4;
    __syncthreads();
#pragma unroll
    for (int i = 0; i < 4; ++i) { const int idx = tid + 512 * i, r = idx >> 7, ch = idx & 127;
        *(LAS bf16x8*)(lds + r * TG_BROW + ch * 16) = *(const bf16x8*)(Bx + (size_t)r * ldb + ch * 8);
        if (DUAL) *(LAS bf16x8*)(lds + 16 * TG_BROW + r * TG_BROW + ch * 16) = *(const bf16x8*)(By + (size_t)r * ldb + ch * 8); }
    __syncthreads();
    for (int rb = wid; rb < nrb; rb += 8) {
        f32x4 ax = {0.f, 0.f, 0.f, 0.f}, ay = {0.f, 0.f, 0.f, 0.f};
        const bf16_t* arow = A + (size_t)(rb * 16 + fr) * lda + fq * 8;
#pragma unroll 8
        for (int ks = 0; ks < 32; ++ks) {
            const bf16x8 af = *(const bf16x8*)(arow + ks * 32);
            const bf16x8 bx = *(const LAS bf16x8*)(lds + fr * TG_BROW + ks * 64 + fq * 16);
            ax = __builtin_amdgcn_mfma_f32_16x16x32_bf16(bx, af, ax, 0, 0, 0);
            if (DUAL) { const bf16x8 af2 = *(const bf16x8*)(arow + aoff_y + ks * 32); const bf16x8 by = *(const LAS bf16x8*)(lds + 16 * TG_BROW + fr * TG_BROW + ks * 64 + fq * 16);
                ay = __builtin_amdgcn_mfma_f32_16x16x32_bf16(by, af2, ay, 0, 0, 0); }
        }
        f(rb * 16 + fr, 4 * fq, ax, ay);
    }
}

__device__ __forceinline__ void p0_transpose_item(const float* W, int ldw, int srccol0, bf16_t* WT, int ldt, int dstrow0, int dstcol0, int k0, LAS float* scr, int lane) {
#pragma unroll 8
    for (int i = 0; i < 32; ++i) { const int kk = 2 * i + (lane >> 5); scr[kk * 33 + (lane & 31)] = W[(size_t)(k0 + kk) * ldw + srccol0 + (lane & 31)]; }
    asm volatile("s_waitcnt lgkmcnt(0)" ::: "memory");
    const int c = lane & 7;
#pragma unroll
    for (int j = 0; j < 4; ++j) { const int n = (lane >> 3) + 8 * j; const LAS float* s = scr + (8 * c) * 33 + n;
        uint4 o; o.x = cvtpk(s[0 * 33], s[1 * 33]); o.y = cvtpk(s[2 * 33], s[3 * 33]); o.z = cvtpk(s[4 * 33], s[5 * 33]); o.w = cvtpk(s[6 * 33], s[7 * 33]);
        *(uint4*)(WT + (size_t)(dstrow0 + n) * ldt + dstcol0 + k0 + 8 * c) = o; }
    asm volatile("s_waitcnt lgkmcnt(0)" ::: "memory");
}
__device__ __forceinline__ void p0_phase(const Params& p, LAS unsigned char* lds, int vcu, int G) {
    const int tid = fresh_tid(), lane = tid & 63, wid = tid >> 6;
    LAS float* scr = (LAS float*)(lds + wid * 16384);
    const int gw = vcu * 8 + wid, NGW = G * 8;
    constexpr int I_IN = 16 * 320, I_SQ = 16 * 32, NITEMS = I_IN + 3 * I_SQ;
    for (int it = gw; it < NITEMS; it += NGW) {
        int r = it;
        if (r < I_IN) { const int kb = r / 320, nb = r % 320; p0_transpose_item(p.w_in, DIN, srccol(32 * nb), WIN_T(p), D, 32 * nb, 0, 64 * kb, scr, lane); continue; } r -= I_IN;
        const int kb = (r % I_SQ) / 32, nb = r % 32;
        if (r < I_SQ) p0_transpose_item(p.w_a, D, 32 * nb, WAB_T(p), 2048, 32 * nb, 0, 64 * kb, scr, lane);
        else if (r < 2 * I_SQ) p0_transpose_item(p.w_b, D, 32 * nb, WAB_T(p), 2048, 32 * nb, 1024, 64 * kb, scr, lane);
        else p0_transpose_item(p.w_o, D, 32 * nb, WO_T(p), D, 32 * nb, 0, 64 * kb, scr, lane);
    }
    for (int r = gw; r < M_MAIN + NXP; r += NGW) {
        uint2* o = (uint2*)(XN(p) + (size_t)r * D) + lane;
        const float* src = nullptr;
        if (r < M_MAIN) src = p.x_prompt + (size_t)r * D; else if (r < M_MAIN + NDEC) src = p.x_sample + (size_t)(r - M_MAIN) * D; else if (r < M_MAIN + NX) src = p.meta + (size_t)(r - M_MAIN - NDEC) * D;
        if (!src) { for (int j = 0; j < 4; ++j) o[64 * j] = make_uint2(0u, 0u); continue; }
        f32x4 v[4]; float s = 0.f;
#pragma unroll
        for (int j = 0; j < 4; ++j) { v[j] = ((const f32x4*)src)[lane + 64 * j]; s += (v[j][0] * v[j][0] + v[j][1] * v[j][1]) + (v[j][2] * v[j][2] + v[j][3] * v[j][3]); }
        const float rs = rsqrtf(wave_sum(s) * (1.f / D) + EPS);
#pragma unroll
        for (int j = 0; j < 4; ++j) { const f32x4 w = ((const f32x4*)p.norm_pre)[lane + 64 * j]; o[64 * j] = make_uint2(cvtpk(v[j][0] * rs * w[0], v[j][1] * rs * w[1]), cvtpk(v[j][2] * rs * w[2], v[j][3] * rs * w[3])); }
    }
}

__device__ __forceinline__ void extras_store(const Params& p, int T, int e, int c, float x, float y) {
    const size_t o = (size_t)e * D + c;
    if (T == 0) { const float lb = lbound(p, c); const float ee = __expf(-clampf(y, -30.f, 30.f)), sg = 1.f / (1.f + ee);
        XA(p, X_Q)[o] = silu(x); XA(p, X_F)[o] = lb + (1.f - lb) * sg; XA(p, X_K)[o] = (1.f - lb) * ee * sg; }
    else if (T == 1) { XA(p, X_V)[o] = x; XA(p, X_SZA)[o] = silu(y); }
    else if (T == 2) { XA(p, X_W)[o] = x * silu(y); }
    else if (T == 3) { XA(p, X_U)[o] = x * y; }
    else { const float ga = sigm(x), gb = sigm(y); XA(p, X_RT)[o] = ga / gb; XA(p, X_GB)[o] = gb; }
}
__device__ __forceinline__ void p1_extras(const Params& p, LAS unsigned char* lds, int vcu, int G) {
    for (int u = vcu; u < 320; u += G) {
        const int T = u / 64, c0 = (u % 64) * 16;
        const bf16_t* bx = WIN_T(p) + (size_t)nrow_x(T, c0) * D;
        auto f = [&](int row, int col, const f32x4& ax, const f32x4& ay) {
            if (row < NX) {
#pragma unroll
                for (int e = 0; e < 4; ++e) extras_store(p, T, row, c0 + col + e, ax[e], ay[e]); } };
        tail_unit<true>(lds, XN(p) + (size_t)M_MAIN * D, D, 0, 9, bx, bx + (size_t)128 * D, D, f);
    }
}
__device__ __forceinline__ void p3a_extras(const Params& p, LAS unsigned char* lds, int vcu, int G) {
    for (int u = vcu; u < 64; u += G) {
        const int n0 = u * 16;
        auto f = [&](int row, int col, const f32x4& ax, const f32x4& ay) {
            const size_t o = (size_t)row * D + n0 + col; const f32x4 rt = *(const f32x4*)(XA(p, X_RT) + o), gb = *(const f32x4*)(XA(p, X_GB) + o);
            const f32x4 m = gb * (rt * ax + ay); *(uint2*)(MGX(p) + o) = make_uint2(cvtpk(m[0], m[1]), cvtpk(m[2], m[3])); };
        tail_unit<true>(lds, A12X(p), 2048, 1024, 8, WAB_T(p) + (size_t)n0 * 2048, WAB_T(p) + (size_t)n0 * 2048 + 1024, 2048, f);
    }
}
__device__ __forceinline__ float* OUTX(const Params& p) { return (float*)(p.ws + WS_MGX + (MiB >> 1)); }
__device__ __forceinline__ float* OUTM(const Params& p) { return (float*)(p.ws + WS_A12); }
__device__ __forceinline__ void p3b_extras(const Params& p, LAS unsigned char* lds, int vcu, int G) {
    for (int u = vcu; u < 64; u += G) {
        const int n0 = u * 16;
        auto f = [&](int row, int col, const f32x4& ax, const f32x4& ay) { *(f32x4*)(OUTX(p) + (size_t)row * D + n0 + col) = ax; };
        tail_unit<false>(lds, MGX(p), D, 0, 8, WO_T(p) + (size_t)n0 * D, nullptr, D, f);
    }
}
__device__ __forceinline__ void p4_phase(const Params& p, int vcu, int G) {
    const int tid4 = fresh_tid(), lane = tid4 & 63, gw = vcu * 8 + (tid4 >> 6), NGW = G * 8;
    for (int r = gw; r < M_MAIN + NDEC; r += NGW) {
        const bool main = r < M_MAIN; const int e = r - M_MAIN;
        const f32x4* o = (const f32x4*)(main ? OUTM(p) + (size_t)r * D : OUTX(p) + (size_t)e * D);
        const f32x4* x = (const f32x4*)(main ? p.x_prompt + (size_t)r * D : p.x_sample + (size_t)e * D);
        f32x4* y = (f32x4*)(main ? p.out + O_YP + (size_t)r * D : p.out + O_YS + (size_t)e * D);
        f32x4 v[4]; float s = 0.f;
#pragma unroll
        for (int j = 0; j < 4; ++j) { v[j] = o[lane + 64 * j]; s += (v[j][0] * v[j][0] + v[j][1] * v[j][1]) + (v[j][2] * v[j][2] + v[j][3] * v[j][3]); }
        const float rs = rsqrtf(wave_sum(s) * (1.f / D) + EPS);
#pragma unroll
        for (int j = 0; j < 4; ++j) { const f32x4 w = ((const f32x4*)p.norm_post)[lane + 64 * j]; y[lane + 64 * j] = x[lane + 64 * j] + v[j] * rs * w; }
    }
}

typedef float f32x16 __attribute__((ext_vector_type(16)));
typedef short s16x4 __attribute__((ext_vector_type(4)));
typedef unsigned u32x4 __attribute__((ext_vector_type(4)));
__device__ __forceinline__ unsigned off_b(unsigned row, unsigned ch) { return 256u * row + 16u * (ch ^ (((row & 3) << 2) | ((row >> 2) & 3))); }
__device__ __forceinline__ s16x4 vtr(LAS const unsigned char* p) { return __builtin_bit_cast(s16x4, __builtin_amdgcn_ds_read_tr16_b64_v4i16((LAS s16x4*)p)); }
__device__ __forceinline__ bf16x8 cat4(s16x4 lo, s16x4 hi) { return __builtin_shufflevector(lo, hi, 0, 1, 2, 3, 4, 5, 6, 7); }
__device__ __forceinline__ bf16x8 pack_step(const f32x16& x, const int s) {
    u32x4 v; v[0] = cvtpk(x[8 * s], x[8 * s + 1]); v[1] = cvtpk(x[8 * s + 2], x[8 * s + 3]); v[2] = cvtpk(x[8 * s + 4], x[8 * s + 5]); v[3] = cvtpk(x[8 * s + 6], x[8 * s + 7]);
    return __builtin_bit_cast(bf16x8, v);
}
#define MFMA32(a, b, c) __builtin_amdgcn_mfma_f32_32x32x16_bf16((a), (b), (c), 0, 0, 0)
constexpr int SC_TILE = 8192, SC_BUF = 3 * SC_TILE, SC_OB = 2 * SC_BUF, SC_OBSZ = 2 * 32 * 128 * 4, SC_DL = SC_OB + 2 * SC_OBSZ;
__device__ __forceinline__ void p2_scan_fast(const Params& p, LAS unsigned char* lds, int b, int h) {
    const int tid = fresh_tid(), lane = tid & 63, wid = tid >> 6, vb = wid >> 1, kh = wid & 1, r32 = lane & 31, hh = lane >> 5;
    const unsigned blk = (lane >> 4) & 1, tq = (lane & 15) >> 2, tp = lane & 3;
    unsigned rowrd[4];
#pragma unroll
    for (int i = 0; i < 4; ++i) rowrd[i] = off_b(r32, 2 * (4 * kh + i) + hh);
    unsigned qperm[2][2][2];
#pragma unroll
    for (int kb = 0; kb < 2; ++kb)
#pragma unroll
        for (int st = 0; st < 2; ++st)
#pragma unroll
            for (int jj = 0; jj < 2; ++jj) qperm[kb][st][jj] = off_b(r32, 4 * (2 * kh + kb) + 2 * st + jj) + 8 * hh;
    unsigned trK[2][2][2], trVn[2][2], trVp[2][2];
#pragma unroll
    for (int ks = 0; ks < 2; ++ks)
#pragma unroll
        for (int t = 0; t < 2; ++t) {
            const unsigned rn = 16 * ks + 8 * hh + 4 * t + tq, rp = 16 * ks + 8 * t + 4 * hh + tq;
#pragma unroll
            for (int kb = 0; kb < 2; ++kb) trK[kb][ks][t] = off_b(rn, 4 * (2 * kh + kb) + 2 * blk + (tp >> 1)) + 8 * (tp & 1);
            trVn[ks][t] = off_b(rn, 4 * vb + 2 * blk + (tp >> 1)) + 8 * (tp & 1);
            trVp[ks][t] = off_b(rp, 4 * vb + 2 * blk + (tp >> 1)) + 8 * (tp & 1);
        }
    f32x16 S[2];
#pragma unroll
    for (int kb = 0; kb < 2; ++kb)
#pragma unroll
        for (int i = 0; i < 16; ++i) S[kb][i] = 0.f;
    for (int j = 0; j < NMETA; ++j) {
        const size_t xo = (size_t)(NDEC + j) * D + h * HD;
        const float vj = XA(p, X_V)[xo + 32 * vb + r32];
#pragma unroll
        for (int kb = 0; kb < 2; ++kb)
#pragma unroll
            for (int g = 0; g < 4; ++g) {
                const int k0 = 32 * (2 * kh + kb) + 8 * g + 4 * hh;
                const f32x4 f = *(const f32x4*)(XA(p, X_F) + xo + k0), kk = *(const f32x4*)(XA(p, X_K) + xo + k0);
#pragma unroll
                for (int e = 0; e < 4; ++e) S[kb][4 * g + e] = f[e] * S[kb][4 * g + e] + kk[e] * vj;
            }
    }
    const int srow = tid >> 4, sch = tid & 15;
    const unsigned swr = off_b(srow, sch);
    const size_t gbase = ((size_t)b * SEQ + srow) * D + (size_t)h * HD + sch * 8;
    const size_t abase = ((size_t)b * SEQ + srow) * 2048 + (size_t)h * HD + sch * 8;
    const float* dlg = DLp(p) + ((size_t)b * (SEQ / CHK)) * D + h * HD + (tid & 31) * 4;
    f32x4 hn0 = *(const f32x4*)(p.hgrn_norm + sch * 8), hn1 = *(const f32x4*)(p.hgrn_norm + sch * 8 + 4);
    u32x4 stq, stk, stv; f32x4 stdl = {0.f, 0.f, 0.f, 0.f};
    stq = *(const u32x4*)(QT(p) + gbase); stk = *(const u32x4*)(KH(p) + gbase); stv = *(const u32x4*)(VV(p) + gbase);
    if (tid < 32) stdl = *(const f32x4*)dlg;
    __syncthreads();
    *(LAS u32x4*)(lds + swr) = stq; *(LAS u32x4*)(lds + SC_TILE + swr) = stk; *(LAS u32x4*)(lds + 2 * SC_TILE + swr) = stv;
    if (tid < 32) *(LAS f32x4*)(lds + SC_DL + tid * 16) = stdl;
    __syncthreads();
    for (int c = 0; c < SEQ / CHK; ++c) {
        const int cur = c & 1;
        LAS const unsigned char* Qi = lds + cur * SC_BUF; LAS const unsigned char* Ki = Qi + SC_TILE; LAS const unsigned char* Vi = Qi + 2 * SC_TILE;
        const bool more = (c + 1) < SEQ / CHK;
        if (more) { const size_t g = gbase + (size_t)(c + 1) * CHK * D; stq = *(const u32x4*)(QT(p) + g); stk = *(const u32x4*)(KH(p) + g); stv = *(const u32x4*)(VV(p) + g);
            if (tid < 32) stdl = *(const f32x4*)(dlg + (size_t)(c + 1) * D); }
        bf16_t* a1 = A12(p) + abase + (size_t)c * CHK * 2048;
        const u32x4 zraw = *(const u32x4*)a1;
        f32x16 pT;
#pragma unroll
        for (int i = 0; i < 16; ++i) pT[i] = 0.f;
#pragma unroll
        for (int i = 0; i < 4; ++i) pT = MFMA32(*(LAS const bf16x8*)(Ki + rowrd[i]), *(LAS const bf16x8*)(Qi + rowrd[i]), pT);
#pragma unroll
        for (int i = 0; i < 16; ++i) { const int s = (i & 3) + 8 * (i >> 2) + 4 * hh; pT[i] = (s <= r32) ? pT[i] : 0.f; }
        f32x16 O;
#pragma unroll
        for (int i = 0; i < 16; ++i) O[i] = 0.f;
#pragma unroll
        for (int kb = 0; kb < 2; ++kb)
#pragma unroll
            for (int st = 0; st < 2; ++st) {
                const bf16x8 qa = cat4(*(LAS const s16x4*)(Qi + qperm[kb][st][0]), *(LAS const s16x4*)(Qi + qperm[kb][st][1]));
                O = MFMA32(qa, pack_step(S[kb], st), O);
            }
#pragma unroll
        for (int st = 0; st < 2; ++st) O = MFMA32(pack_step(pT, st), cat4(vtr(Vi + trVp[st][0]), vtr(Vi + trVp[st][1])), O);
        { LAS float* ob = (LAS float*)(lds + SC_OB + cur * SC_OBSZ + kh * 16384) + 32 * vb + r32;
#pragma unroll
          for (int i = 0; i < 16; ++i) ob[((i & 3) + 8 * (i >> 2) + 4 * hh) * 128] = O[i]; }
#pragma unroll
        for (int ks = 0; ks < 2; ++ks) {
            const bf16x8 vf = cat4(vtr(Vi + trVn[ks][0]), vtr(Vi + trVn[ks][1]));
#pragma unroll
            for (int kb = 0; kb < 2; ++kb) S[kb] = MFMA32(cat4(vtr(Ki + trK[kb][ks][0]), vtr(Ki + trK[kb][ks][1])), vf, S[kb]);
        }
#pragma unroll
        for (int kb = 0; kb < 2; ++kb)
#pragma unroll
            for (int g = 0; g < 4; ++g) { const f32x4 d = *(LAS const f32x4*)(lds + SC_DL + cur * 512 + (32 * (2 * kh + kb) + 8 * g + 4 * hh) * 4);
#pragma unroll
                for (int e = 0; e < 4; ++e) S[kb][4 * g + e] *= d[e]; }
        if (more) { LAS unsigned char* nb = lds + (cur ^ 1) * SC_BUF;
            *(LAS u32x4*)(nb + swr) = stq; *(LAS u32x4*)(nb + SC_TILE + swr) = stk; *(LAS u32x4*)(nb + 2 * SC_TILE + swr) = stv;
            if (tid < 32) *(LAS f32x4*)(lds + SC_DL + (cur ^ 1) * 512 + tid * 16) = stdl; }
        __syncthreads();
        { LAS const float* o0 = (LAS const float*)(lds + SC_OB + cur * SC_OBSZ) + srow * 128 + sch * 8;
          f32x4 a = *(LAS const f32x4*)o0 + *(LAS const f32x4*)(o0 + 4096), bb = *(LAS const f32x4*)(o0 + 4) + *(LAS const f32x4*)(o0 + 4096 + 4);
          float ss = (a[0] * a[0] + a[1] * a[1]) + (a[2] * a[2] + a[3] * a[3]) + (bb[0] * bb[0] + bb[1] * bb[1]) + (bb[2] * bb[2] + bb[3] * bb[3]);
          ss += __shfl_xor(ss, 8); ss += __shfl_xor(ss, 4); ss += __shfl_xor(ss, 2); ss += __shfl_xor(ss, 1);
          const float rs = rsqrtf(ss * (1.f / 128.f) + EPS);
          f32x4 z0, z1; { uint4 zr; zr.x = zraw[0]; zr.y = zraw[1]; zr.z = zraw[2]; zr.w = zraw[3]; unpack8v(zr, z0, z1); }
          const uint4 w = pack8v(a * rs * hn0 * z0, bb * rs * hn1 * z1);
          u32x4 wv; wv[0] = w.x; wv[1] = w.y; wv[2] = w.z; wv[3] = w.w; *(u32x4*)a1 = wv; }
    }
    float* hp = p.out + O_HP + ((size_t)b * NH + h) * 128 * 128 + 32 * vb + r32;
#pragma unroll
    for (int kb = 0; kb < 2; ++kb)
#pragma unroll
        for (int i = 0; i < 16; ++i) hp[(size_t)(32 * (2 * kh + kb) + (i & 3) + 8 * (i >> 2) + 4 * hh) * 128] = S[kb][i];
    __syncthreads();
}

__device__ __forceinline__ void p2_scan_simple(const Params& p, float* sm, int b, int h) {
    float* S = sm;
    float* q = S + 128 * 128;
    float* kh = q + 32 * 128;
    float* vv = kh + 32 * 128;
    float* O = vv + 32 * 128;
    float* P = O + 32 * 128;
    float* dl = P + 32 * 33;
    const int tid = threadIdx.x;
    for (int i = tid; i < 128 * 128; i += 512) S[i] = 0.f;
    __syncthreads();
    for (int j = 0; j < NMETA; ++j) {
        const size_t xo = (size_t)(NDEC + j) * D + h * HD;
        for (int i = tid; i < 128 * 128; i += 512) { const int k = i >> 7, v = i & 127; S[i] = XA(p, X_F)[xo + k] * S[i] + XA(p, X_K)[xo + k] * XA(p, X_V)[xo + v]; }
    }
    __syncthreads();
    for (int c = 0; c < SEQ / CHK; ++c) {
        const size_t row0 = (size_t)b * SEQ + c * CHK;
        for (int i = tid; i < 32 * 128; i += 512) { const int t = i >> 7, k = i & 127; const size_t g = (row0 + t) * D + h * HD + k; q[i] = bf2f(QT(p)[g]); kh[i] = bf2f(KH(p)[g]); vv[i] = bf2f(VV(p)[g]); }
        if (tid < 128) dl[tid] = DLp(p)[((size_t)b * (SEQ / CHK) + c) * D + h * HD + tid];
        __syncthreads();
        for (int i = tid; i < 1024; i += 512) { const int t = i >> 5, s = i & 31; float a = 0.f; if (s <= t) for (int k = 0; k < 128; ++k) a += q[t * 128 + k] * kh[s * 128 + k]; P[t * 33 + s] = a; }
        __syncthreads();
        for (int i = tid; i < 4096; i += 512) { const int t = i >> 7, v = i & 127; float a = 0.f; for (int k = 0; k < 128; ++k) a += q[t * 128 + k] * S[k * 128 + v]; for (int s = 0; s <= t; ++s) a += P[t * 33 + s] * vv[s * 128 + v]; O[i] = a; }
        __syncthreads();
        for (int i = tid; i < 128 * 128; i += 512) { const int k = i >> 7, v = i & 127; float a = S[i]; for (int s = 0; s < 32; ++s) a += kh[s * 128 + k] * vv[s * 128 + v]; S[i] = dl[k] * a; }
        { const int t = tid >> 4, v0 = (tid & 15) * 8; float ss = 0.f;
#pragma unroll
          for (int j = 0; j < 8; ++j) { const float x = O[t * 128 + v0 + j]; ss += x * x; }
          for (int o = 8; o > 0; o >>= 1) ss += __shfl_xor(ss, o);
          const float rs = rsqrtf(ss * (1.f / 128.f) + EPS); bf16_t* a1 = A12(p) + (row0 + t) * 2048 + h * HD + v0; f32x4 z0, z1; unpack8v(*(const uint4*)a1, z0, z1);
#pragma unroll
          for (int j = 0; j < 4; ++j) { z0[j] = O[t * 128 + v0 + j] * rs * p.hgrn_norm[v0 + j] * z0[j]; z1[j] = O[t * 128 + v0 + 4 + j] * rs * p.hgrn_norm[v0 + 4 + j] * z1[j]; }
          *(uint4*)a1 = pack8v(z0, z1); }
        __syncthreads();
    }
    float* hp = p.out + O_HP + ((size_t)b * NH + h) * 128 * 128;
    for (int i = tid; i < 128 * 128; i += 512) hp[i] = S[i];
    __syncthreads();
}
__device__ __forceinline__ void p2_decode_unit(const Params& p, float* sm, int n, int h) {
    float* red = sm;
    float* ssq = sm + 2048;
    const int tid = threadIdx.x, kq = tid >> 5, v4 = tid & 31;
    const size_t xo = (size_t)n * D + h * HD;
    const float* S = p.state_hgrn + ((size_t)n * NH + h) * 128 * 128; float* So = p.out + O_HS + ((size_t)n * NH + h) * 128 * 128;
    const f32x4 vv = *(const f32x4*)(XA(p, X_V) + xo + v4 * 4);
    f32x4 o = {0.f, 0.f, 0.f, 0.f};
    f32x4 s[8];
#pragma unroll
    for (int i = 0; i < 8; ++i) s[i] = *(const f32x4*)(S + (kq * 8 + i) * 128 + v4 * 4);
#pragma unroll
    for (int i = 0; i < 8; ++i) { const int k = kq * 8 + i; const float f = XA(p, X_F)[xo + k], kk = XA(p, X_K)[xo + k], qq = XA(p, X_Q)[xo + k];
        s[i] = f * s[i] + kk * vv; *(f32x4*)(So + k * 128 + v4 * 4) = s[i]; o += qq * s[i]; }
    __syncthreads();
    *(f32x4*)&red[kq * 128 + v4 * 4] = o;
    __syncthreads();
    float ov = 0.f;
    if (tid < 128) { for (int i = 0; i < 16; ++i) ov += red[i * 128 + tid]; float ss = ov * ov; for (int o2 = 32; o2 > 0; o2 >>= 1) ss += __shfl_xor(ss, o2); if ((tid & 63) == 0) ssq[tid >> 6] = ss; }
    __syncthreads();
    if (tid < 128) { const float rs = rsqrtf((ssq[0] + ssq[1]) * (1.f / 128.f) + EPS); A12X(p)[(size_t)n * 2048 + h * HD + tid] = f2bf(ov * rs * p.hgrn_norm[tid] * XA(p, X_SZA)[xo + tid]); }
}
__device__ __forceinline__ void p2_conv_item(const Params& p, int row, int c0) {
    f32x4 cw[3][2];
#pragma unroll
    for (int j = 0; j < 3; ++j) { cw[j][0] = *(const f32x4*)(p.conv_w + j * D + c0); cw[j][1] = *(const f32x4*)(p.conv_w + j * D + c0 + 4); }
    if (row < M_MAIN) {
        const int t = row & (SEQ - 1); f32x4 u0[2], u1[2], u2[2], w[2];
        unpack8v(*(const uint4*)(UU(p) + (size_t)row * D + c0), u2[0], u2[1]);
        if (t >= 1) unpack8v(*(const uint4*)(UU(p) + (size_t)(row - 1) * D + c0), u1[0], u1[1]); else { const float* m = XA(p, X_U) + (size_t)(NDEC + 15) * D + c0; u1[0] = *(const f32x4*)m; u1[1] = *(const f32x4*)(m + 4); }
        if (t >= 2) unpack8v(*(const uint4*)(UU(p) + (size_t)(row - 2) * D + c0), u0[0], u0[1]); else { const float* m = XA(p, X_U) + (size_t)(NDEC + 14 + t) * D + c0; u0[0] = *(const f32x4*)m; u0[1] = *(const f32x4*)(m + 4); }
        bf16_t* a2 = A12(p) + (size_t)row * 2048 + 1024 + c0; unpack8v(*(const uint4*)a2, w[0], w[1]);
#pragma unroll
        for (int n = 0; n < 2; ++n) w[n] *= cw[0][n] * u0[n] + cw[1][n] * u1[n] + cw[2][n] * u2[n];
        *(uint4*)a2 = pack8v(w[0], w[1]);
    } else {
        const int n = row - M_MAIN; const float* ctx = p.state_conv + (size_t)n * 2 * D + c0; float* cs = p.out + O_CS + (size_t)n * 2 * D + c0; f32x4 w[2];
#pragma unroll
        for (int q = 0; q < 2; ++q) { const f32x4 u = *(const f32x4*)(XA(p, X_U) + (size_t)n * D + c0 + 4 * q), c0v = *(const f32x4*)(ctx + 4 * q), c1v = *(const f32x4*)(ctx + D + 4 * q);
            w[q] = *(const f32x4*)(XA(p, X_W) + (size_t)n * D + c0 + 4 * q) * (cw[0][q] * c0v + cw[1][q] * c1v + cw[2][q] * u); *(f32x4*)(cs + 4 * q) = c1v; *(f32x4*)(cs + D + 4 * q) = u; }
        *(uint4*)(A12X(p) + (size_t)n * 2048 + 1024 + c0) = pack8v(w[0], w[1]);
    }
}
#ifndef SCAN_SIMPLE
#define SCAN_SIMPLE 0
#endif
__device__ __forceinline__ void p2_phase_v1(const Params& p, unsigned char* lds, int bx, int G) {
    float* sm = (float*)lds;
    if (bx < 64) { if (SCAN_SIMPLE) p2_scan_simple(p, sm, bx >> 3, bx & 7); else p2_scan_fast(p, (LAS unsigned char*)lds, bx >> 3, bx & 7); return; }
    const int w = bx - 64, NW = G - 64;
    for (int u = w; u < NDEC * NH; u += NW) p2_decode_unit(p, sm, u >> 3, u & 7);
    const size_t nitems = (size_t)(M_MAIN + NDEC) * 128;
    for (size_t it = (size_t)w * 512 + threadIdx.x; it < nitems; it += (size_t)NW * 512) p2_conv_item(p, (int)(it >> 7), (int)(it & 127) * 8);
}

#define XB_TMO      128
#define XB_XCNT(j)  (256  + 64 * (j))
#define XB_XSUB(j)  (1280 + 64 * (j))
#define XB_XGEN(j)  (2304 + 64 * (j))
#define XB_TOP      3328
#define XB_TOPGEN   3392
#define XCD_BAR_WORDS 3456
#define XB_SPIN_CAP (1u << 18)
__device__ __forceinline__ unsigned xb_ld(unsigned* p)              { return __hip_atomic_load(p, __ATOMIC_RELAXED, __HIP_MEMORY_SCOPE_AGENT); }
__device__ __forceinline__ unsigned xb_add(unsigned* p, unsigned v) { return __hip_atomic_fetch_add(p, v, __ATOMIC_RELAXED, __HIP_MEMORY_SCOPE_AGENT); }
__device__ __forceinline__ unsigned xb_xcc_id() { return (unsigned)__builtin_amdgcn_s_getreg((3 << 11) | 20) & 0xFu; }
#define XB_SPIN(cond, bar) do { unsigned _sp = 0; while (cond) { __builtin_amdgcn_s_sleep(1); \
    if ((++_sp & 255u) == 0u) { if (xb_ld(&(bar)[XB_TMO])) break; if (_sp > XB_SPIN_CAP) { atomicAdd(&(bar)[XB_TMO], 1u); break; } } } } while (0)
struct XcdBarrier { unsigned* bar; unsigned x; volatile LAS unsigned* st; };
__device__ __forceinline__ XcdBarrier xcd_barrier_post(unsigned* bar, volatile LAS unsigned* st) {
    XcdBarrier b; b.bar = bar; b.x = xb_xcc_id(); b.st = st;
    if (threadIdx.x == 0) (void)xb_add(&bar[XB_XCNT(b.x)], 1u);
    return b;
}
__device__ __forceinline__ void xcd_barrier_complete(unsigned* bar, unsigned x, unsigned& nloc, unsigned& nx) {
    const unsigned G = gridDim.x * gridDim.y * gridDim.z;
    unsigned sum, cnt, mine, sp = 0u;
    for (;;) {
        sum = 0u; cnt = 0u; mine = 0u;
#pragma unroll
        for (unsigned j = 0; j < 16; ++j) { const unsigned c = xb_ld(&bar[XB_XCNT(j)]); sum += c; cnt += (c > 0u) ? 1u : 0u; mine = (j == x) ? c : mine; }
        if (sum == G) break;
        __builtin_amdgcn_s_sleep(1);
        if ((++sp & 255u) == 0u) { if (xb_ld(&bar[XB_TMO])) break; if (sp > XB_SPIN_CAP) { atomicAdd(&bar[XB_TMO], 1u); break; } }
    }
    nloc = mine > 0u ? mine : 1u; nx = cnt > 0u ? cnt : 1u;
}
__device__ __forceinline__ void xcd_barrier(const XcdBarrier& b) {
    asm volatile("s_waitcnt vmcnt(0)" ::: "memory");
    __syncthreads();
    if (threadIdx.x == 0) {
        unsigned* bar = b.bar;
        __builtin_amdgcn_s_waitcnt(0);
        unsigned nloc = b.st[0], nx = b.st[1];
        if (nloc == 0u) { xcd_barrier_complete(bar, b.x, nloc, nx); b.st[0] = nloc; b.st[1] = nx; }
        const unsigned old = xb_add(&bar[XB_XSUB(b.x)], 1u);
        const unsigned gen = old / nloc;
        if (old + 1u == (gen + 1u) * nloc) {
            __builtin_amdgcn_fence(__ATOMIC_RELEASE, "agent");
            asm volatile("s_waitcnt vmcnt(0)" ::: "memory");
            const unsigned og = xb_add(&bar[XB_TOP], 1u);
            const unsigned tg = og / nx;
            if (og + 1u == (tg + 1u) * nx) xb_add(&bar[XB_TOPGEN], 1u);
            else XB_SPIN(xb_ld(&bar[XB_TOPGEN]) == tg, bar);
            __builtin_amdgcn_fence(__ATOMIC_ACQUIRE, "agent");
            xb_add(&bar[XB_XGEN(b.x)], 1u);
            asm volatile("s_waitcnt vmcnt(0)" ::: "memory");
        } else {
            XB_SPIN(xb_ld(&bar[XB_XGEN(b.x)]) == gen, bar);
            __builtin_amdgcn_fence(__ATOMIC_ACQUIRE, "agent");
            asm volatile("s_waitcnt vmcnt(0)" ::: "memory");
        }
    }
    __syncthreads();
}

constexpr int LDS_BYTES = 147456;
constexpr int MISC_OFF = LDS_BYTES - 256;
constexpr int CW_BAR = 4096;
constexpr size_t CTL_ZERO_BYTES = 65536;
#ifndef MK_N_LAUNCHES
#define MK_N_LAUNCHES 1
#endif
constexpr int NPHASE = 6;
struct Args { Params p; int ph_lo, ph_hi; };
__global__ void __launch_bounds__(512, 2) mega_fwd(Args a) {
    extern __shared__ __attribute__((aligned(16))) unsigned char lds_raw[];
    LAS unsigned char* lds = (LAS unsigned char*)lds_raw;
    const Params& p = a.p;
    const int tid = threadIdx.x, G = gridDim.x, bx = blockIdx.x;
    const int vcu = (G % 8 == 0) ? (bx % 8) * (G / 8) + bx / 8 : bx;
    volatile LAS unsigned* MISC = (volatile LAS unsigned*)(lds + MISC_OFF);
    if (tid < 64) MISC[tid] = 0u;
    __syncthreads();
    XcdBarrier bar; bar.bar = (unsigned*)(p.ws + WS_CTL) + CW_BAR; bar.x = 0; bar.st = nullptr;
    if (MK_N_LAUNCHES == 1) bar = xcd_barrier_post((unsigned*)(p.ws + WS_CTL) + CW_BAR, MISC + 8);
    const int lo = a.ph_lo, hi = a.ph_hi;
#define IN(k) (lo <= (k) && (k) < hi)
#define SEAM(k) do { if (IN(k) && IN((k) + 1)) xcd_barrier(bar); } while (0)
    if (IN(0)) { p0_phase(p, lds, vcu, G); }
    SEAM(0);
    if (IN(1)) {
        pg8::Gemm g{XN(p), WIN_T(p), M_MAIN, DIN, D}; pg8::StaticOrder S; S.init(M_MAIN, DIN, G, bx);
        EpiP1 E{p};
        pg8::gemm_phase<EpiP1, pg8::StaticOrder, true, true, false>(lds, g, S, E);
        p1_extras(p, lds, vcu, G);
    }
    SEAM(1);
    if (IN(2)) { p2_phase_v1(p, lds_raw, bx, G); }
    SEAM(2);
    if (IN(3)) {
        pg8::Gemm g{A12(p), WAB_T(p), M_MAIN, D, 2048}; pg8::StaticOrder S; S.init(M_MAIN, D, G, bx);
        EpiMG E{p};
        pg8::gemm_phase<EpiMG, pg8::StaticOrder, false, true, true>(lds, g, S, E);
        p3a_extras(p, lds, vcu, G);
    }
    SEAM(3);
    if (IN(4)) {
        pg8::Gemm g{MG(p), WO_T(p), M_MAIN, D, D}; pg8::StaticOrder S; S.init(M_MAIN, D, G, bx);
        EpiOut E{OUTM(p)};
        pg8::gemm_phase<EpiOut, pg8::StaticOrder, false, true, false>(lds, g, S, E);
        p3b_extras(p, lds, vcu, G);
    }
    SEAM(4);
    if (IN(5)) { p4_phase(p, vcu, G); }
#undef IN
#undef SEAM
}

extern "C" void kernel_launch(void* const* d_in, const int* in_sizes, int n_in, void* d_out, int out_size, void* d_ws, size_t ws_size, hipStream_t stream) {
    static int grid = 0;
    if (grid == 0) {
        int dev = 0, cus = 0;
        if (hipGetDevice(&dev) != hipSuccess || hipDeviceGetAttribute(&cus, hipDeviceAttributeMultiprocessorCount, dev) != hipSuccess) { fprintf(stderr, "kernel_launch: device query failed\n"); grid = -1; return; }
        if (hipFuncSetAttribute((const void*)mega_fwd, hipFuncAttributeMaxDynamicSharedMemorySize, LDS_BYTES) != hipSuccess) { fprintf(stderr, "kernel_launch: hipFuncSetAttribute failed\n"); grid = -1; return; }
        int per_cu = 0;
        if (hipOccupancyMaxActiveBlocksPerMultiprocessor(&per_cu, (const void*)mega_fwd, 512, LDS_BYTES) != hipSuccess || per_cu < 1) fprintf(stderr, "kernel_launch: occupancy query reports %d blocks/CU\n", per_cu);
        (void)hipGetLastError();
        grid = cus;
        if (grid != 256) fprintf(stderr, "kernel_launch: %d CUs (built for 256)\n", grid);
    }
    if (grid < 0) return;
    (void)hipMemsetAsync((char*)d_ws + WS_CTL, 0, CTL_ZERO_BYTES, stream);
    Args a{};
    a.p.x_prompt = (const float*)d_in[0]; a.p.x_sample = (const float*)d_in[1]; a.p.state_hgrn = (const float*)d_in[2]; a.p.state_conv = (const float*)d_in[3]; a.p.meta = (const float*)d_in[4];
    a.p.w_in = (const float*)d_in[5]; a.p.norm_pre = (const float*)d_in[6]; a.p.norm_post = (const float*)d_in[7]; a.p.lb_logits = (const float*)d_in[8]; a.p.hgrn_norm = (const float*)d_in[9];
    a.p.conv_w = (const float*)d_in[10]; a.p.w_a = (const float*)d_in[11]; a.p.w_b = (const float*)d_in[12]; a.p.w_o = (const float*)d_in[13];
    a.p.out = (float*)d_out; a.p.ws = (unsigned char*)d_ws;
    if (MK_N_LAUNCHES == 1) { a.ph_lo = 0; a.ph_hi = NPHASE; hipLaunchKernelGGL(mega_fwd, dim3(grid), dim3(512), LDS_BYTES, stream, a); }
    else for (int k = 0; k < NPHASE; ++k) { a.ph_lo = k; a.ph_hi = k + 1; hipLaunchKernelGGL(mega_fwd, dim3(grid), dim3(512), LDS_BYTES, stream, a); }
}
```
